# Optimizing an MI355X kernel written in HIP

```python
import jax
import jax.numpy as jnp
from jax import lax
import numpy as np

D_MODEL = 1024
BATCH = 8
SEQ = 4096
DEPTH = 4

D_A = D_MODEL // 2
A_HEAD_DIM = 128
A_HEADS = D_A // A_HEAD_DIM
A_CHUNK = 64
D_B = D_MODEL // 4
B_BLOCKS = 4
B_BLOCK_DIM = D_B // B_BLOCKS
CONV_WIDTH = 4
LRU_C = 8.0
D_C = D_MODEL // 4
C_GROUPS = 4
C_GROUP_DIM = D_C // C_GROUPS
C_CHUNK = 128

D_MIX = D_A + D_B + D_C
SPLIT_SIZES = (D_A, D_A, D_A, D_A, D_B, D_B, D_C, D_C)
D_IN = sum(SPLIT_SIZES)
D_FF = ((8 * D_MODEL // 3 + 127) // 128) * 128
EPS = 1e-6

kernel_name = 'hybrid_hgrn2_rglru_sgu_macaron'


def rmsnorm(x, gain):
    x32 = x.astype(jnp.float32)
    y = x32 * lax.rsqrt(jnp.mean(x32 * x32, axis=-1, keepdims=True) + EPS)
    return (y * gain.astype(jnp.float32)).astype(x.dtype)


def group_rmsnorm(x, gain, n_groups):
    shp = x.shape
    x32 = x.astype(jnp.float32).reshape(shp[:-1] + (n_groups, shp[-1] // n_groups))
    y = x32 * lax.rsqrt(jnp.mean(x32 * x32, axis=-1, keepdims=True) + EPS)
    return y.reshape(shp) * gain.astype(jnp.float32)


def swiglu(x, w_gate, w_up, w_down):
    return (jax.nn.silu(x @ w_gate) * (x @ w_up)) @ w_down


def hgrn2(q, f_logit, i, g, lower_bound, norm_gain):
    bsz, seq, _ = q.shape
    n_chunks = seq // A_CHUNK
    f32 = jnp.float32
    q = jax.nn.silu(q.astype(f32))
    lb = lower_bound.astype(f32)
    forget = lb + (1.0 - lb) * jax.nn.sigmoid(f_logit.astype(f32))
    k = 1.0 - forget
    log_f = jnp.log(forget)

    def to_chunks(t):
        return t.reshape(bsz, n_chunks, A_CHUNK, A_HEADS, A_HEAD_DIM).transpose(1, 0, 3, 2, 4)

    qc, kc, vc = to_chunks(q), to_chunks(k), to_chunks(i.astype(f32))
    bc = jnp.cumsum(to_chunks(log_f), axis=3)
    causal = jnp.tril(jnp.ones((A_CHUNK, A_CHUNK), bool))[:, :, None]

    def chunk_step(state, inp):
        q_t, k_t, v_t, b_t = inp
        diff = jnp.where(causal, b_t[:, :, :, None, :] - b_t[:, :, None, :, :], -jnp.inf)
        scores = jnp.einsum('bhtk,bhtsk,bhsk->bhts', q_t, jnp.exp(diff), k_t)
        out = (jnp.einsum('bhts,bhsv->bhtv', scores, v_t)
               + jnp.einsum('bhtk,bhkv->bhtv', q_t * jnp.exp(b_t), state))
        b_end = b_t[:, :, -1:, :]
        state = (jnp.exp(b_end[:, :, 0, :, None]) * state
                 + jnp.einsum('bhsk,bhsv->bhkv', k_t * jnp.exp(b_end - b_t), v_t))
        return state, out

    state0 = jnp.zeros((bsz, A_HEADS, A_HEAD_DIM, A_HEAD_DIM), f32)
    _, o = lax.scan(chunk_step, state0, (qc, kc, vc, bc))
    o = o.transpose(1, 0, 3, 2, 4).reshape(bsz, seq, D_A)
    o = group_rmsnorm(o, norm_gain, A_HEADS) * jax.nn.silu(g.astype(f32))
    return o.astype(g.dtype)


def rglru(xb, gate, conv_w, conv_b, w_a, b_a, w_x, b_x, lam, norm_gain):
    bsz, seq, _ = xb.shape
    f32 = jnp.float32
    xp = jnp.pad(xb, ((0, 0), (CONV_WIDTH - 1, 0), (0, 0)))
    xc = conv_b + xp[:, 0:seq] * conv_w[0]
    for tap in range(1, CONV_WIDTH):
        xc = xc + xp[:, tap:tap + seq] * conv_w[tap]
    xh = xc.reshape(bsz, seq, B_BLOCKS, B_BLOCK_DIM)
    r = jax.nn.sigmoid((jnp.einsum('blhi,hij->blhj', xh, w_a) + b_a).astype(f32)).reshape(bsz, seq, D_B)
    gate_in = jax.nn.sigmoid((jnp.einsum('blhi,hij->blhj', xh, w_x) + b_x).astype(f32)).reshape(bsz, seq, D_B)
    log_a = -LRU_C * r * jax.nn.softplus(-lam.astype(f32))
    a = jnp.exp(log_a)
    mult = jnp.sqrt(-jnp.expm1(2.0 * log_a))
    u = mult * gate_in * xc.astype(f32)

    def combine(left, right):
        return right[0] * left[0], right[0] * left[1] + right[1]

    _, h = lax.associative_scan(combine, (a, u), axis=1)
    y = h * jax.nn.gelu(gate.astype(f32))
    return group_rmsnorm(y, norm_gain, B_BLOCKS).astype(xb.dtype)


def chunked_sgu(u_in, v_in, w_s, b_s, norm_gain):
    bsz, seq, _ = u_in.shape
    n_chunks = seq // C_CHUNK
    f32 = jnp.float32
    u = jax.nn.gelu(u_in.astype(f32))
    v = jax.nn.gelu(v_in.astype(f32)).reshape(bsz, n_chunks, C_CHUNK, C_GROUPS, C_GROUP_DIM)
    mu = jnp.mean(v, axis=-1, keepdims=True)
    var = jnp.mean(jnp.square(v - mu), axis=-1, keepdims=True)
    v = (v - mu) * lax.rsqrt(var + EPS)
    w = w_s.astype(f32) * jnp.tril(jnp.ones((C_CHUNK, C_CHUNK), f32))
    z = jnp.einsum('gts,bnsgc->bntgc', w, v) + b_s.astype(f32).T[:, :, None]
    y = u * z.reshape(bsz, seq, D_C)
    return group_rmsnorm(y, norm_gain, C_GROUPS).astype(u_in.dtype)


def setup_inputs(seed: int = 0) -> dict:
    key = jax.random.key(seed)
    ks = jax.random.split(key, 32)
    f32 = jnp.float32

    def nrm(k, shape, scale):
        return jax.random.normal(k, shape, f32) * scale

    def gain(k, shape):
        return 1.0 + 0.05 * jax.random.normal(k, shape, f32)

    a0 = jax.random.uniform(ks[15], (DEPTH, D_B), f32, 0.9, 0.999)
    lam = jnp.log(a0) - jnp.log1p(-a0)
    return {
        'x': jax.random.normal(ks[0], (BATCH, SEQ, D_MODEL), f32),
        'ffn1_norm': gain(ks[1], (DEPTH, D_MODEL)),
        'ffn1_wg': nrm(ks[2], (DEPTH, D_MODEL, D_FF), D_MODEL ** -0.5),
        'ffn1_wu': nrm(ks[3], (DEPTH, D_MODEL, D_FF), D_MODEL ** -0.5),
        'ffn1_wd': nrm(ks[4], (DEPTH, D_FF, D_MODEL), D_FF ** -0.5),
        'mix_norm': gain(ks[5], (DEPTH, D_MODEL)),
        'w_in': nrm(ks[6], (DEPTH, D_MODEL, D_IN), D_MODEL ** -0.5),
        'hgrn_lb_logits': nrm(ks[7], (DEPTH, D_A), 0.5),
        'hgrn_norm': gain(ks[8], (DEPTH, D_A)),
        'conv_w': nrm(ks[9], (DEPTH, CONV_WIDTH, D_B), CONV_WIDTH ** -0.5),
        'conv_b': nrm(ks[10], (DEPTH, D_B), 0.02),
        'lru_wa': nrm(ks[11], (DEPTH, B_BLOCKS, B_BLOCK_DIM, B_BLOCK_DIM), B_BLOCK_DIM ** -0.5),
        'lru_ba': nrm(ks[12], (DEPTH, B_BLOCKS, B_BLOCK_DIM), 0.02),
        'lru_wx': nrm(ks[13], (DEPTH, B_BLOCKS, B_BLOCK_DIM, B_BLOCK_DIM), B_BLOCK_DIM ** -0.5),
        'lru_bx': nrm(ks[14], (DEPTH, B_BLOCKS, B_BLOCK_DIM), 0.02),
        'lru_lambda': lam,
        'lru_norm': gain(ks[16], (DEPTH, D_B)),
        'sgu_w': nrm(ks[17], (DEPTH, C_GROUPS, C_CHUNK, C_CHUNK), C_CHUNK ** -0.5),
        'sgu_b': gain(ks[18], (DEPTH, C_GROUPS, C_CHUNK)),
        'sgu_norm': gain(ks[19], (DEPTH, D_C)),
        'w_out': nrm(ks[20], (DEPTH, D_MIX, D_MODEL), D_MIX ** -0.5),
        'ffn2_norm': gain(ks[21], (DEPTH, D_MODEL)),
        'ffn2_wg': nrm(ks[22], (DEPTH, D_MODEL, D_FF), D_MODEL ** -0.5),
        'ffn2_wu': nrm(ks[23], (DEPTH, D_MODEL, D_FF), D_MODEL ** -0.5),
        'ffn2_wd': nrm(ks[24], (DEPTH, D_FF, D_MODEL), D_FF ** -0.5),
        'final_norm': gain(ks[25], (D_MODEL,)),
    }


def reference(x, ffn1_norm, ffn1_wg, ffn1_wu, ffn1_wd, mix_norm, w_in, hgrn_lb_logits, hgrn_norm,
              conv_w, conv_b, lru_wa, lru_ba, lru_wx, lru_bx, lru_lambda, lru_norm,
              sgu_w, sgu_b, sgu_norm, w_out, ffn2_norm, ffn2_wg, ffn2_wu, ffn2_wd, final_norm):
    lb_soft = jax.nn.softmax(hgrn_lb_logits.astype(jnp.float32), axis=0)
    lower_bounds = jnp.cumsum(lb_soft, axis=0) - lb_soft[0]
    split_points = [int(p) for p in np.cumsum(SPLIT_SIZES)[:-1]]
    h = x
    for layer in range(DEPTH):
        h = h + 0.5 * swiglu(rmsnorm(h, ffn1_norm[layer]), ffn1_wg[layer], ffn1_wu[layer], ffn1_wd[layer])
        z = rmsnorm(h, mix_norm[layer]) @ w_in[layer]
        q, f_logit, i, g, xb, gate, u, v = jnp.split(z, split_points, axis=-1)
        out_a = hgrn2(q, f_logit, i, g, lower_bounds[layer], hgrn_norm[layer])
        out_b = rglru(xb, gate, conv_w[layer], conv_b[layer], lru_wa[layer], lru_ba[layer],
                      lru_wx[layer], lru_bx[layer], lru_lambda[layer], lru_norm[layer])
        out_c = chunked_sgu(u, v, sgu_w[layer], sgu_b[layer], sgu_norm[layer])
        h = h + jnp.concatenate([out_a, out_b, out_c], axis=-1) @ w_out[layer]
        h = h + 0.5 * swiglu(rmsnorm(h, ffn2_norm[layer]), ffn2_wg[layer], ffn2_wu[layer], ffn2_wd[layer])
    return rmsnorm(h, final_norm)
```

```cpp
#include <hip/hip_runtime.h>
#include <hip/hip_cooperative_groups.h>
#include <cstdio>
#include <cstdint>
namespace cg = cooperative_groups;
namespace pg8 {
#define PG8_LAS __attribute__((address_space(3)))
typedef unsigned short bf16_t;
typedef short bf16x8 __attribute__((ext_vector_type(8)));
typedef float f32x4 __attribute__((ext_vector_type(4)));
typedef unsigned u32x4 __attribute__((ext_vector_type(4)));
constexpr int BM = 256, BK = 64, HALF = 128, HTB = HALF * BK * 2  , STAGE_BYTES = 8 * HTB, NXCD = 8, WGM = 8;

__host__ __device__ __forceinline__ int lds_byte(int r, int c) { const int st = (r >> 4) * 2 + (c >> 5), rr = r & 15, cc = c & 31, ob = rr * 64 + cc * 2; return st * 1024 + (ob ^ (((ob >> 9) & 1) << 5)); }
__host__ __device__ __forceinline__ void stage_rc(int b, int& R, int& C) { const int st = b / 1024, sb = b % 1024, swz = sb ^ (((sb >> 9) & 1) << 5); R = (st >> 1) * 16 + swz / 64; C = (st & 1) * 32 + (swz % 64) / 2; }
__host__ __device__ __forceinline__ int perm32(int rho) { const int n = rho >> 4, i = rho & 15; return 8 * (i >> 2) + 4 * n + (i & 3); }

struct Unit { int pm, pn; };
struct Gemm { const bf16_t* A; const bf16_t* Bt; int M, N, K; };

struct StaticOrder {
    int nM, nN, nwg, G, c;
    __host__ __device__ void init(int M, int N, int G_, int c_) { nM = M / BM; nN = N / BM; nwg = nM * nN; G = G_; c = c_; }
    __host__ __device__ bool next(int i, Unit& u) const {
        const long L = (long)i * G + c; if (L >= nwg) return false;
        int wgid = (int)L; { const int q = nwg / NXCD, r = nwg % NXCD, xcd = wgid % NXCD, off = wgid / NXCD; wgid = (xcd < r ? xcd * (q + 1) : r * (q + 1) + (xcd - r) * q) + off; }
        const int nig = WGM * nN, gid = wgid / nig, fm = gid * WGM, gsz = (nM - fm) < WGM ? (nM - fm) : WGM;
        u.pm = fm + ((wgid % nig) % gsz); u.pn = (wgid % nig) / gsz; return true;
    }
    __device__ __forceinline__ void a_ready(const Unit&) const {}
    __device__ __forceinline__ void done(const Unit&) const {}
};

typedef __bf16 bf16x2_t __attribute__((ext_vector_type(2)));
typedef float f32x2_t __attribute__((ext_vector_type(2)));
__device__ __forceinline__ unsigned cvt_pk_bf16(float lo, float hi) { f32x2_t v = {lo, hi}; bf16x2_t b = __builtin_convertvector(v, bf16x2_t); return __builtin_bit_cast(unsigned, b); }
__device__ __forceinline__ float fsigmoid(float x) { return __builtin_amdgcn_rcpf(1.0f + __expf(-x)); }
struct EpiSwiGLU {
    static constexpr bool PERM = true, AFTER_DRAIN = false;
    bf16_t* O; int ldc;
    __device__ __forceinline__ void operator()(const f32x4 (&acc)[2][2][4][2], const Unit& u, int wr, int wc, int fr, int fq) const {
        const int row0 = u.pm * BM + wr * 64 + fr, col0 = u.pn * HALF + wc * 32 + 8 * fq;
#pragma unroll
        for (int ai = 0; ai < 2; ++ai)
#pragma unroll
            for (int m = 0; m < 4; ++m) { bf16_t* rowp = O + (size_t)(row0 + ai * HALF + m * 16) * ldc + col0;
                float v[8];
#pragma unroll
                for (int n = 0; n < 2; ++n)
#pragma unroll
                    for (int j = 0; j < 4; ++j) { const float g = acc[ai][0][m][n][j], up = acc[ai][1][m][n][j]; v[n * 4 + j] = g * fsigmoid(g) * up; }
                u32x4 w; w.x = cvt_pk_bf16(v[0], v[1]); w.y = cvt_pk_bf16(v[2], v[3]); w.z = cvt_pk_bf16(v[4], v[5]); w.w = cvt_pk_bf16(v[6], v[7]);
                *(u32x4*)rowp = w; }
    }
};
struct EpiStoreBf16 {
    static constexpr bool PERM = true, AFTER_DRAIN = false;
    bf16_t* O; int ldc;
    __device__ __forceinline__ void operator()(const f32x4 (&acc)[2][2][4][2], const Unit& u, int wr, int wc, int fr, int fq) const {
        const int row0 = u.pm * BM + wr * 64 + fr, col0 = u.pn * BM + wc * 32 + 8 * fq;
#pragma unroll
        for (int ai = 0; ai < 2; ++ai)
#pragma unroll
            for (int m = 0; m < 4; ++m) { bf16_t* rowp = O + (size_t)(row0 + ai * HALF + m * 16) * ldc + col0;
#pragma unroll
                for (int bj = 0; bj < 2; ++bj) { const f32x4 v0 = acc[ai][bj][m][0], v1 = acc[ai][bj][m][1];
                    u32x4 w; w.x = cvt_pk_bf16(v0[0], v0[1]); w.y = cvt_pk_bf16(v0[2], v0[3]); w.z = cvt_pk_bf16(v1[0], v1[1]); w.w = cvt_pk_bf16(v1[2], v1[3]);
                    *(u32x4*)(rowp + bj * HALF) = w; } }
    }
};
struct EpiResidual {
    static constexpr bool PERM = false, AFTER_DRAIN = false;
    float* H; int ldc; float scale;
    __device__ __forceinline__ void operator()(const f32x4 (&acc)[2][2][4][2], const Unit& u, int wr, int wc, int fr, int fq) const {
        const int col0 = u.pn * BM + wc * 32 + 4 * fq;
#pragma unroll
        for (int ai = 0; ai < 2; ++ai)
#pragma unroll
            for (int m = 0; m < 4; ++m) { float* rowp = H + (size_t)(u.pm * BM + ai * HALF + wr * 64 + m * 16 + fr) * ldc + col0;
#pragma unroll
                for (int bj = 0; bj < 2; ++bj)
#pragma unroll
                    for (int n = 0; n < 2; ++n) { f32x4* p = (f32x4*)(rowp + bj * HALF + n * 16); const f32x4 o = *p + acc[ai][bj][m][n] * scale; *p = o; }
                asm volatile("" ::: "memory"); }
    }
};
template <class Epi, class Sched, bool ALIGN_EPI = false, bool SP2 = false>
__device__ __forceinline__ void gemm_phase(PG8_LAS unsigned char* lds, const Gemm g, const Sched& S, const Epi& E) {
    const int tid = threadIdx.x, wid = __builtin_amdgcn_readfirstlane(tid >> 6), lane = tid & 63, wr = wid >> 2, wc = wid & 3, fr = lane & 15, fq = lane >> 4;
    const int K = g.K, nt = K / BK;
    unsigned voffA[2], voffB[2];
#pragma unroll
    for (int i = 0; i < 2; ++i) { int R, C; stage_rc(tid * 16 + i * 8192, R, C); const int Rb = Epi::PERM ? ((R & ~31) + perm32(R & 31)) : R;
        voffA[i] = (unsigned)(R * K + C) * 2u; voffB[i] = (unsigned)(Rb * K + C) * 2u; }
    const size_t kstep = (size_t)(BK * 2);
    const size_t hstep = (size_t)HALF * K * 2;
    const size_t tstep = 2 * hstep;
    const unsigned ldsw = (unsigned)wid * 1024u;
    const int aoff = lds_byte(wr * 64 + fr, fq * 8), boff = lds_byte(wc * 32 + fr, fq * 8);
#define PG8_SA(b, h) (((b) * 2 + (h)) * HTB)
#define PG8_SB(b, h) ((4 + (b) * 2 + (h)) * HTB)
#define PG8_STAGE(bufoff, gbase, voff) do { _Pragma("unroll") for (int _i = 0; _i < 2; ++_i) \
        __builtin_amdgcn_global_load_lds((const unsigned*)((const char*)(gbase) + (voff)[_i]), (PG8_LAS unsigned*)(lds + (bufoff) + ldsw + _i * 8192), 16, 0, 0); } while (0)
#define PG8_LDA(dst, b, h) do { _Pragma("unroll") for (int m = 0; m < 4; ++m) _Pragma("unroll") for (int k = 0; k < 2; ++k) dst[m][k] = *(const PG8_LAS bf16x8*)(lds + PG8_SA(b, h) + aoff + m * 2048 + k * 1024); } while (0)
#define PG8_LDB(dst, b, h) do { _Pragma("unroll") for (int n = 0; n < 2; ++n) _Pragma("unroll") for (int k = 0; k < 2; ++k) dst[n][k] = *(const PG8_LAS bf16x8*)(lds + PG8_SB(b, h) + boff + n * 2048 + k * 1024); } while (0)
#define PG8_MMA(ai, bj, At, Bt) do { __builtin_amdgcn_s_setprio(1); _Pragma("unroll") for (int m = 0; m < 4; ++m) _Pragma("unroll") for (int n = 0; n < 2; ++n) _Pragma("unroll") for (int k = 0; k < 2; ++k) \
        acc[ai][bj][m][n] = __builtin_amdgcn_mfma_f32_16x16x32_bf16(Bt[n][k], At[m][k], acc[ai][bj][m][n], 0, 0, 0); __builtin_amdgcn_s_setprio(0); } while (0)
#define PG8_WAIT_V(n) asm volatile("s_waitcnt vmcnt(" #n ")" ::: "memory")
#define PG8_WAIT_L(n) asm volatile("s_waitcnt lgkmcnt(" #n ")" ::: "memory")
#define PG8_BAR __builtin_amdgcn_s_barrier()
#define PG8_SCHED __builtin_amdgcn_sched_barrier(0)
    Unit cur, nxt; int ui = 0;
    if (!S.next(0, cur)) return;
    f32x4 acc[2][2][4][2];
#pragma unroll
    for (int a = 0; a < 2; ++a)
#pragma unroll
        for (int b = 0; b < 2; ++b)
#pragma unroll
            for (int m = 0; m < 4; ++m)
#pragma unroll
                for (int n = 0; n < 2; ++n) acc[a][b][m][n] = (f32x4){0.f, 0.f, 0.f, 0.f};
    bf16x8 At[4][2], B0[2][2], B1[2][2];
    const char* cA = (const char*)g.A + (size_t)cur.pm * tstep; const char* cB = (const char*)g.Bt + (size_t)cur.pn * tstep;
    S.a_ready(cur);
    if constexpr (SP2) {
        PG8_STAGE(PG8_SB(0, 0), cB, voffB); PG8_STAGE(PG8_SB(0, 1), cB + hstep, voffB); PG8_STAGE(PG8_SA(0, 0), cA, voffA); PG8_STAGE(PG8_SA(0, 1), cA + hstep, voffA);
        if (wr == 1) PG8_BAR;
        PG8_WAIT_V(2); PG8_BAR;
        PG8_STAGE(PG8_SB(1, 0), cB + kstep, voffB); PG8_STAGE(PG8_SA(1, 0), cA + kstep, voffA); PG8_STAGE(PG8_SB(1, 1), cB + hstep + kstep, voffB);
        PG8_WAIT_V(6); PG8_BAR;
    } else {
        PG8_STAGE(PG8_SB(0, 0), cB, voffB); PG8_STAGE(PG8_SA(0, 0), cA, voffA); PG8_STAGE(PG8_SB(0, 1), cB + hstep, voffB); PG8_STAGE(PG8_SA(0, 1), cA + hstep, voffA);
        if (wr == 1) PG8_BAR;
        PG8_WAIT_V(4); PG8_BAR;
        PG8_STAGE(PG8_SB(1, 0), cB + kstep, voffB); PG8_STAGE(PG8_SA(1, 0), cA + kstep, voffA); PG8_STAGE(PG8_SB(1, 1), cB + hstep + kstep, voffB);
        PG8_WAIT_V(6); PG8_BAR;
    }
    for (;;) {
        const bool has_next = S.next(ui + 1, nxt);
        const char* nA = has_next ? (const char*)g.A + (size_t)nxt.pm * tstep : cA; const char* nB = has_next ? (const char*)g.Bt + (size_t)nxt.pn * tstep : cB;
        for (int t = 0; t < nt; t += 2) {
            const bool last = (t == nt - 2);
            const char* a1 = cA + (size_t)(t + 1) * kstep;
            const char* a2 = last ? nA : cA + (size_t)(t + 2) * kstep; const char* b2 = last ? nB : cB + (size_t)(t + 2) * kstep;
            const char* a3 = a2 + kstep; const char* b3 = b2 + kstep;
            if (last && has_next) S.a_ready(nxt);
            if constexpr (SP2) {
            PG8_LDB(B0, 0, 0); PG8_LDB(B1, 0, 1); PG8_SCHED; PG8_LDA(At, 0, 0); PG8_STAGE(PG8_SA(1, 1), a1 + hstep, voffA);
            PG8_WAIT_V(8); PG8_WAIT_L(0); PG8_BAR; PG8_MMA(0, 0, At, B0); PG8_MMA(0, 1, At, B1); PG8_BAR; PG8_SCHED;
            PG8_LDA(At, 0, 1); PG8_STAGE(PG8_SB(0, 0), b2, voffB); PG8_STAGE(PG8_SB(0, 1), b2 + hstep, voffB); PG8_STAGE(PG8_SA(0, 0), a2, voffA);
            PG8_WAIT_V(8); PG8_WAIT_L(0); PG8_BAR; PG8_MMA(1, 0, At, B0); PG8_MMA(1, 1, At, B1); PG8_BAR; PG8_SCHED;
            PG8_LDB(B0, 1, 0); PG8_LDB(B1, 1, 1); PG8_SCHED; PG8_LDA(At, 1, 0); PG8_STAGE(PG8_SA(0, 1), a2 + hstep, voffA);
            PG8_WAIT_V(8); PG8_WAIT_L(0); PG8_BAR; PG8_MMA(0, 0, At, B0); PG8_MMA(0, 1, At, B1); PG8_BAR; PG8_SCHED;
            PG8_LDA(At, 1, 1); PG8_STAGE(PG8_SB(1, 0), b3, voffB); PG8_STAGE(PG8_SB(1, 1), b3 + hstep, voffB); PG8_STAGE(PG8_SA(1, 0), a3, voffA);
            PG8_WAIT_V(8); PG8_WAIT_L(0); PG8_BAR; PG8_MMA(1, 0, At, B0); PG8_MMA(1, 1, At, B1); PG8_BAR; PG8_SCHED;
            } else {
            PG8_LDB(B0, 0, 0); PG8_SCHED; PG8_LDA(At, 0, 0); PG8_STAGE(PG8_SA(1, 1), a1 + hstep, voffA);
            PG8_WAIT_L(8); PG8_BAR; PG8_WAIT_L(0); PG8_MMA(0, 0, At, B0); PG8_BAR; PG8_SCHED;
            PG8_LDB(B1, 0, 1); PG8_STAGE(PG8_SB(0, 0), b2, voffB);
            PG8_BAR; PG8_WAIT_L(0); PG8_MMA(0, 1, At, B1); PG8_BAR;
            PG8_LDA(At, 0, 1); PG8_STAGE(PG8_SA(0, 0), a2, voffA);
            PG8_BAR; PG8_WAIT_L(0); PG8_MMA(1, 0, At, B0); PG8_BAR; PG8_SCHED;
            PG8_STAGE(PG8_SB(0, 1), b2 + hstep, voffB);
            PG8_WAIT_V(6); PG8_BAR; PG8_MMA(1, 1, At, B1); PG8_BAR;
            PG8_LDB(B0, 1, 0); PG8_SCHED; PG8_LDA(At, 1, 0); PG8_STAGE(PG8_SA(0, 1), a2 + hstep, voffA);
            PG8_WAIT_L(8); PG8_BAR; PG8_WAIT_L(0); PG8_MMA(0, 0, At, B0); PG8_BAR; PG8_SCHED;
            PG8_LDB(B1, 1, 1); PG8_STAGE(PG8_SB(1, 0), b3, voffB);
            PG8_BAR; PG8_WAIT_L(0); PG8_MMA(0, 1, At, B1); PG8_BAR;
            PG8_LDA(At, 1, 1); PG8_STAGE(PG8_SA(1, 0), a3, voffA);
            PG8_BAR; PG8_WAIT_L(0); PG8_MMA(1, 0, At, B0); PG8_BAR; PG8_SCHED;
            PG8_STAGE(PG8_SB(1, 1), b3 + hstep, voffB);
            PG8_WAIT_V(6); PG8_BAR; PG8_MMA(1, 1, At, B1); PG8_BAR;
            }
        }
        if constexpr (ALIGN_EPI) { if (wr == 0) PG8_BAR; }
        if constexpr (!Epi::AFTER_DRAIN) { E(acc, cur, wr, wc, fr, fq); S.done(cur); }
        if (!has_next) break;
#pragma unroll
        for (int a = 0; a < 2; ++a)
#pragma unroll
            for (int b = 0; b < 2; ++b)
#pragma unroll
                for (int m = 0; m < 4; ++m)
#pragma unroll
                    for (int n = 0; n < 2; ++n) acc[a][b][m][n] = (f32x4){0.f, 0.f, 0.f, 0.f};
        cur = nxt; cA = nA; cB = nB; ++ui;
        if constexpr (ALIGN_EPI) { if (wr == 1) PG8_BAR; }
    }
    PG8_WAIT_V(0);
    if constexpr (!ALIGN_EPI) { if (wr == 0) PG8_BAR; }
    PG8_BAR;
    if constexpr (Epi::AFTER_DRAIN) { E.fused(acc, cur, wr, wc, fr, fq, lds, wid, lane); S.done(cur); }
#undef PG8_SA
#undef PG8_SB
#undef PG8_STAGE
#undef PG8_LDA
#undef PG8_LDB
#undef PG8_MMA
#undef PG8_WAIT_V
#undef PG8_WAIT_L
#undef PG8_BAR
#undef PG8_SCHED
}
}

#define LAS __attribute__((address_space(3)))
typedef unsigned short bf16;
typedef short bf16x8 __attribute__((ext_vector_type(8)));
typedef float f32x4 __attribute__((ext_vector_type(4)));
typedef unsigned u32x4 __attribute__((ext_vector_type(4)));
typedef unsigned u32x2 __attribute__((ext_vector_type(2)));
using pg8::cvt_pk_bf16;
using pg8::fsigmoid;

#ifndef HG_SCALE
#define HG_SCALE 1.0f
#endif
#ifndef LR_SCALE
#define LR_SCALE 1.0f
#endif
#ifndef SG_SCALE
#define SG_SCALE 1.0f
#endif
#ifndef GEMM_MASK
#define GEMM_MASK 0
#endif
constexpr int NWAVES = 8, NTHREADS = 512;
constexpr int DEPTH = 4, BATCH = 8, SEQ = 4096, D = 1024, T = BATCH * SEQ, FF = 2816, DIN = 3072;
constexpr float EPS = 1e-6f;
constexpr int LDS_BYTES = 147456;
constexpr int ZQ = 0, ZF = 512, ZI = 1024, ZG = 1536, ZX = 2048, ZGATE = 2304, ZU = 2560, ZV = 2816;
constexpr size_t MiB = 1u << 20;
constexpr size_t W_GU = (size_t)2 * FF * D * 2, W_D = (size_t)D * FF * 2, W_IN = (size_t)DIN * D * 2, W_OUT = (size_t)D * D * 2;
constexpr size_t OFF_GU1 = 0, OFF_D1 = OFF_GU1 + W_GU, OFF_IN = OFF_D1 + W_D, OFF_OUT = OFF_IN + W_IN, OFF_GU2 = OFF_OUT + W_OUT, OFF_D2 = OFF_GU2 + W_GU, W_LAYER = OFF_D2 + W_D;
constexpr size_t WS_W = 1 * MiB, WS_XN = WS_W + DEPTH * W_LAYER, WS_Z = WS_XN + (size_t)T * D * 2, WS_HS = WS_Z + (size_t)T * DIN * 2, WS_HD = WS_HS + (size_t)256 * 65536, WS_LE = WS_HD + 256 * 512, WS_LH = WS_LE + 256 * 512, WS_LP = WS_LH + (size_t)T * 256 * 4, WS_END = WS_LP + (size_t)T * 256 * 4;

struct Args { const float* in[26]; float* out; unsigned char* ws; };
typedef const Args __attribute__((address_space(4))) CArgs;
enum { I_X = 0, I_F1N, I_F1G, I_F1U, I_F1D, I_MIXN, I_WIN, I_LB, I_HN, I_CW, I_CB, I_WA, I_BA, I_WX, I_BX, I_LAM, I_LN, I_SW, I_SB, I_SN, I_WOUT, I_F2N, I_F2G, I_F2U, I_F2D, I_FN };

__device__ __forceinline__ float bf2f(unsigned short h) { return __uint_as_float((unsigned)h << 16); }
__device__ __forceinline__ unsigned short f2bf(float f) { return (unsigned short)(cvt_pk_bf16(f, 0.f) & 0xffffu); }
__device__ __forceinline__ float gelu_t(float x) { return x * fsigmoid(1.5957691216f * (x + 0.044715f * x * x * x)); }
__device__ __forceinline__ float silu_f(float x) { return x * fsigmoid(x); }
__device__ __forceinline__ float wave_sum(float v) {
#pragma unroll
    for (int o = 1; o < 64; o <<= 1) v += __shfl_xor(v, o);
    return v;
}
#define BLOCK_SYNC() do { asm volatile("s_waitcnt lgkmcnt(0)" ::: "memory"); __builtin_amdgcn_s_barrier(); asm volatile("" ::: "memory"); } while (0)
__device__ __forceinline__ int opaque_tid() { int t = threadIdx.x; asm volatile("" : "+v"(t)); return t; }

__device__ __forceinline__ void transpose_item(const float* W, int K, int N, bf16* WT, int k0, int n0, int drow0, LAS float* scr, int lane) {
#pragma unroll 8
    for (int i = 0; i < 32; ++i) { const int kk = 2 * i + (lane >> 5); scr[kk * 33 + (lane & 31)] = W[(size_t)(k0 + kk) * N + n0 + (lane & 31)]; }
    asm volatile("s_waitcnt lgkmcnt(0)" ::: "memory");
    const int c = lane & 7;
#pragma unroll
    for (int j = 0; j < 4; ++j) { const int n = (lane >> 3) + 8 * j; const LAS float* s = scr + (8 * c) * 33 + n;
        u32x4 o; o.x = cvt_pk_bf16(s[0 * 33], s[1 * 33]); o.y = cvt_pk_bf16(s[2 * 33], s[3 * 33]); o.z = cvt_pk_bf16(s[4 * 33], s[5 * 33]); o.w = cvt_pk_bf16(s[6 * 33], s[7 * 33]);
        *(u32x4*)(WT + (size_t)(drow0 + n) * K + k0 + 8 * c) = o; }
    asm volatile("s_waitcnt lgkmcnt(0)" ::: "memory");
}
__device__ __forceinline__ void convert_weights(CArgs& a, LAS unsigned char* lds, int gw, int NGW, int wave, int lane) {
    LAS float* scr = (LAS float*)(lds + wave * 16384);
    constexpr int I_FFU = (D / 64) * (FF / 32), I_FFD = (FF / 64) * (D / 32), I_IN_ = (D / 64) * (DIN / 32), I_OUT_ = (D / 64) * (D / 32);
    constexpr int PER_LAYER = 4 * I_FFU + 2 * I_FFD + I_IN_ + I_OUT_;
    for (int it = gw; it < DEPTH * PER_LAYER; it += NGW) {
        const int layer = it / PER_LAYER; int r = it % PER_LAYER;
        bf16* wl = (bf16*)(a.ws + WS_W + (size_t)layer * W_LAYER);
        const float* src; int K, N; bf16* dst; int mode = 0;
        if (r < I_FFU) { src = a.in[I_F1G] + (size_t)layer * D * FF; K = D; N = FF; dst = wl + OFF_GU1 / 2; mode = 1; }
        else if ((r -= I_FFU) < I_FFU) { src = a.in[I_F1U] + (size_t)layer * D * FF; K = D; N = FF; dst = wl + OFF_GU1 / 2; mode = 2; }
        else if ((r -= I_FFU) < I_FFD) { src = a.in[I_F1D] + (size_t)layer * D * FF; K = FF; N = D; dst = wl + OFF_D1 / 2; }
        else if ((r -= I_FFD) < I_IN_) { src = a.in[I_WIN] + (size_t)layer * D * DIN; K = D; N = DIN; dst = wl + OFF_IN / 2; }
        else if ((r -= I_IN_) < I_OUT_) { src = a.in[I_WOUT] + (size_t)layer * D * D; K = D; N = D; dst = wl + OFF_OUT / 2; }
        else if ((r -= I_OUT_) < I_FFU) { src = a.in[I_F2G] + (size_t)layer * D * FF; K = D; N = FF; dst = wl + OFF_GU2 / 2; mode = 1; }
        else if ((r -= I_FFU) < I_FFU) { src = a.in[I_F2U] + (size_t)layer * D * FF; K = D; N = FF; dst = wl + OFF_GU2 / 2; mode = 2; }
        else { r -= I_FFU; src = a.in[I_F2D] + (size_t)layer * D * FF; K = FF; N = D; dst = wl + OFF_D2 / 2; }
        const int nblk = N / 32, kb = r / nblk, nb = r % nblk, n0 = 32 * nb;
        const int drow0 = mode == 0 ? n0 : ((n0 >> 7) * 256 + (n0 & 127) + (mode == 2 ? 128 : 0));
        transpose_item(src, K, N, dst, 64 * kb, n0, drow0, scr, lane);
    }
}
template <bool FINAL>
__device__ __forceinline__ void norm_rows(const float* src, const bf16* y, float ys, float* hdst, const float* gain, bf16* xn, float* fout, int gw, int NGW, int lane) {
    f32x4 gv[4];
#pragma unroll
    for (int j = 0; j < 4; ++j) gv[j] = ((const f32x4*)gain)[lane + 64 * j];
    for (int m0 = gw; m0 < T; m0 += 2 * NGW) {
        f32x4 v[2][4]; u32x2 yw[2][4];
#pragma unroll
        for (int r = 0; r < 2; ++r) { const int m = m0 + r * NGW; const f32x4* xr = (const f32x4*)(src + (size_t)m * D) + lane;
#pragma unroll
            for (int j = 0; j < 4; ++j) v[r][j] = xr[64 * j];
            if (y) { const u32x2* yr = (const u32x2*)(y + (size_t)m * D) + lane;
#pragma unroll
                for (int j = 0; j < 4; ++j) yw[r][j] = yr[64 * j]; } }
        float s[2];
#pragma unroll
        for (int r = 0; r < 2; ++r) { s[r] = 0.f;
            if (y) {
#pragma unroll
                for (int j = 0; j < 4; ++j) { const u32x2 w = yw[r][j];
                    v[r][j].x += ys * __uint_as_float(w.x << 16); v[r][j].y += ys * __uint_as_float(w.x & 0xffff0000u); v[r][j].z += ys * __uint_as_float(w.y << 16); v[r][j].w += ys * __uint_as_float(w.y & 0xffff0000u); } }
#pragma unroll
            for (int j = 0; j < 4; ++j) s[r] += (v[r][j].x * v[r][j].x + v[r][j].y * v[r][j].y) + (v[r][j].z * v[r][j].z + v[r][j].w * v[r][j].w); }
#pragma unroll
        for (int o = 1; o < 64; o <<= 1) { s[0] += __shfl_xor(s[0], o); s[1] += __shfl_xor(s[1], o); }
#pragma unroll
        for (int r = 0; r < 2; ++r) { const int m = m0 + r * NGW; const float rstd = rsqrtf(s[r] * (1.f / D) + EPS);
            if (!FINAL && hdst) { f32x4* hr = (f32x4*)(hdst + (size_t)m * D) + lane;
#pragma unroll
                for (int j = 0; j < 4; ++j) hr[64 * j] = v[r][j]; }
            if (FINAL) { f32x4* o = (f32x4*)(fout + (size_t)m * D) + lane;
#pragma unroll
                for (int j = 0; j < 4; ++j) o[64 * j] = v[r][j] * rstd * gv[j];
            } else { u32x2* o = (u32x2*)(xn + (size_t)m * D) + lane;
#pragma unroll
                for (int j = 0; j < 4; ++j) { const f32x4 q = v[r][j] * rstd * gv[j]; u32x2 w; w.x = cvt_pk_bf16(q.x, q.y); w.y = cvt_pk_bf16(q.z, q.w); o[64 * j] = w; } } }
    }
}

template <int KSTEPS>
__device__ __forceinline__ f32x4 mma16(const LAS bf16* A, int lda, const LAS bf16* B, int ldb, f32x4 acc, int fr, int fq) {
    const LAS bf16* ap = A + fr * lda + fq * 8; const LAS bf16* bp = B + fr * ldb + fq * 8;
#pragma unroll
    for (int kk = 0; kk < KSTEPS; ++kk) {
        const bf16x8 av = *(const LAS bf16x8*)(ap + kk * 32); const bf16x8 bv = *(const LAS bf16x8*)(bp + kk * 32);
        acc = __builtin_amdgcn_mfma_f32_16x16x32_bf16(bv, av, acc, 0, 0, 0);
    }
    return acc;
}

constexpr int QLD = 136, SLD = 72;
constexpr int NSEG = 8, SEG_CHUNKS = SEQ / 64 / NSEG;
template <bool FULL>
__device__ __forceinline__ void hgrn_seg(CArgs& a, LAS unsigned char* lds, int layer, int item, const bf16* z, bf16* mix, float* HS, float* HD) {
    const int tid = opaque_tid(), lane = tid & 63, wave = tid >> 6, fr = lane & 15, fq = lane >> 4;
    const int b = item >> 5, hd = (item >> 3) & 3, sgi = item & 7;
    LAS bf16* Q = (LAS bf16*)(lds);
    LAS bf16* Kt = (LAS bf16*)(lds + 17408);
    LAS bf16* KsT = (LAS bf16*)(lds + 34816);
    LAS bf16* VT = (LAS bf16*)(lds + 53248);
    LAS bf16* S = (LAS bf16*)(lds + 71680);
    LAS bf16* StT = (LAS bf16*)(lds + 80896);
    LAS float* dk = (LAS float*)(lds + 115712);
    LAS float* seg = (LAS float*)(lds + 116224);
    LAS float* red = (LAS float*)(lds + 118272);
    const int ch = tid & 127, tq = tid >> 7;
    float lb;
    { const float* lg = a.in[I_LB] + hd * 128 + ch; const float l0 = lg[0], l1 = lg[512], l2 = lg[1024], l3 = lg[1536];
      const float mx = fmaxf(fmaxf(l0, l1), fmaxf(l2, l3)); const float e0 = __expf(l0 - mx), e1 = __expf(l1 - mx), e2 = __expf(l2 - mx), e3 = __expf(l3 - mx);
      const float inv = 1.f / (e0 + e1 + e2 + e3); lb = (layer >= 1 ? e1 : 0.f) + (layer >= 2 ? e2 : 0.f) + (layer >= 3 ? e3 : 0.f); lb *= inv; }
    const float oml = 1.f - lb;
    f32x4 st[8];
#pragma unroll
    for (int i = 0; i < 8; ++i) st[i] = (f32x4){0.f, 0.f, 0.f, 0.f};
    if (FULL) {
        for (int j = 0; j < sgi; ++j) { const float* Sj = HS + (size_t)(item - sgi + j) * 16384 + (16 * wave + fr) * 128 + 4 * fq; const float* Dj = HD + (item - sgi + j) * 128 + 4 * fq;
#pragma unroll
            for (int kb = 0; kb < 8; ++kb) st[kb] = st[kb] * *(const f32x4*)(Dj + 16 * kb) + *(const f32x4*)(Sj + 16 * kb); }
#pragma unroll
        for (int kb = 0; kb < 8; ++kb) { u32x2 w; w.x = cvt_pk_bf16(st[kb][0], st[kb][1]); w.y = cvt_pk_bf16(st[kb][2], st[kb][3]);
            *(LAS u32x2*)(StT + (16 * wave + fr) * QLD + 16 * kb + 4 * fq) = w; }
    }
    const int tb = wave & 3, vh = wave >> 2;
    const float* gn = a.in[I_HN] + layer * 512 + hd * 128;
    float dsum = 1.f;
    f32x4 ggv[4];
    if (FULL) {
#pragma unroll
        for (int i = 0; i < 4; ++i) ggv[i] = *(const f32x4*)(gn + 16 * ((wave >> 2) * 4 + i) + 4 * fq); }
    unsigned short rf[16], rq[16], ri[16];
    const size_t tseg = (size_t)b * SEQ + (size_t)sgi * SEG_CHUNKS * 64;
    { const bf16* zr = z + (tseg + tq * 16) * DIN + hd * 128 + ch;
#pragma unroll
      for (int j = 0; j < 16; ++j) { rf[j] = zr[(size_t)j * DIN + ZF]; ri[j] = zr[(size_t)j * DIN + ZI]; if (FULL) rq[j] = zr[(size_t)j * DIN + ZQ]; } }
    BLOCK_SYNC();
    for (int c = 0; c < SEG_CHUNKS; ++c) {
        const size_t t0 = tseg + c * 64;
        float bl[16], kv[16]; float run = 1.f;
#pragma unroll
        for (int j = 0; j < 16; ++j) { const float x = fminf(fmaxf(bf2f(rf[j]), -30.f), 30.f); const float e = __expf(-x), sg = __builtin_amdgcn_rcpf(1.f + e);
            const float f = lb + oml * sg; run *= f; bl[j] = run; kv[j] = oml * e * sg; }
        seg[tq * 128 + ch] = run;
        BLOCK_SYNC();
        float prefix = 1.f, total = 1.f;
#pragma unroll
        for (int q = 0; q < 4; ++q) { const float sv = seg[q * 128 + ch]; total *= sv; if (q < tq) prefix *= sv; }
        dsum *= total;
        unsigned ksp[8], vip[8];
#pragma unroll
        for (int j = 0; j < 16; j += 2) {
            float ks2[2];
#pragma unroll
            for (int jj = 0; jj < 2; ++jj) { const int t = j + jj; const float e1 = fmaxf(prefix * bl[t], 1e-35f), e2 = __builtin_amdgcn_rcpf(e1);
                if (FULL) { const float qx = bf2f(rq[t]); const float qv = qx * fsigmoid(qx);
                    Q[(tq * 16 + t) * QLD + ch] = f2bf(qv * e1);
                    Kt[(tq * 16 + t) * QLD + ch] = f2bf(kv[t] * e2); }
                ks2[jj] = kv[t] * (total * e2); }
            ksp[j >> 1] = cvt_pk_bf16(ks2[0], ks2[1]); vip[j >> 1] = (unsigned)ri[j] | ((unsigned)ri[j + 1] << 16);
        }
        { LAS u32x4* kp = (LAS u32x4*)(KsT + ch * SLD + tq * 16); kp[0] = (u32x4){ksp[0], ksp[1], ksp[2], ksp[3]}; kp[1] = (u32x4){ksp[4], ksp[5], ksp[6], ksp[7]};
          LAS u32x4* vp = (LAS u32x4*)(VT + ch * SLD + tq * 16); vp[0] = (u32x4){vip[0], vip[1], vip[2], vip[3]}; vp[1] = (u32x4){vip[4], vip[5], vip[6], vip[7]}; }
        if (tq == 0) dk[ch] = total;
        if (c + 1 < SEG_CHUNKS) { const bf16* zr = z + (t0 + 64 + tq * 16) * DIN + hd * 128 + ch;
#pragma unroll
            for (int j = 0; j < 16; ++j) { rf[j] = zr[(size_t)j * DIN + ZF]; ri[j] = zr[(size_t)j * DIN + ZI]; if (FULL) rq[j] = zr[(size_t)j * DIN + ZQ]; } }
        u32x2 gwv[4];
        if (FULL) { const bf16* gr = z + (t0 + 16 * tb + fr) * DIN + ZG + hd * 128;
#pragma unroll
            for (int i = 0; i < 4; ++i) gwv[i] = *(const u32x2*)(gr + 16 * (vh * 4 + i) + 4 * fq); }
        BLOCK_SYNC();
        if (FULL) {
#pragma unroll
        for (int i = 0; i < 2; ++i) { const int sb = vh * 2 + i;
            f32x4 acc = (f32x4){0.f, 0.f, 0.f, 0.f};
            if (sb <= tb) acc = mma16<4>(Q + 16 * tb * QLD, QLD, Kt + 16 * sb * QLD, QLD, acc, fr, fq);
            const int t = 16 * tb + fr, s0 = 16 * sb + 4 * fq;
            u32x2 w; w.x = cvt_pk_bf16(s0 <= t ? acc[0] : 0.f, s0 + 1 <= t ? acc[1] : 0.f); w.y = cvt_pk_bf16(s0 + 2 <= t ? acc[2] : 0.f, s0 + 3 <= t ? acc[3] : 0.f);
            *(LAS u32x2*)(S + t * SLD + s0) = w; }
        BLOCK_SYNC();
        f32x4 o[4]; float ss = 0.f;
#pragma unroll
        for (int i = 0; i < 4; ++i) { const int vb = vh * 4 + i;
            f32x4 acc = (f32x4){0.f, 0.f, 0.f, 0.f};
            acc = mma16<2>(S + 16 * tb * SLD, SLD, VT + 16 * vb * SLD, SLD, acc, fr, fq);
            acc = mma16<4>(Q + 16 * tb * QLD, QLD, StT + 16 * vb * QLD, QLD, acc, fr, fq);
            o[i] = acc; ss += (acc[0] * acc[0] + acc[1] * acc[1]) + (acc[2] * acc[2] + acc[3] * acc[3]); }
        ss += __shfl_xor(ss, 16); ss += __shfl_xor(ss, 32);
        if (fq == 0) red[vh * 64 + 16 * tb + fr] = ss;
        BLOCK_SYNC();
        { const int t = 16 * tb + fr; const float rs = rsqrtf((red[t] + red[64 + t]) * (1.f / 128.f) + EPS);
          bf16* mr = mix + (t0 + t) * D + hd * 128;
#pragma unroll
          for (int i = 0; i < 4; ++i) { const int v0 = 16 * (vh * 4 + i) + 4 * fq;
              const u32x2 gw = gwv[i]; const f32x4 gg = ggv[i];
              const float g0 = __uint_as_float(gw.x << 16), g1 = __uint_as_float(gw.x & 0xffff0000u), g2 = __uint_as_float(gw.y << 16), g3 = __uint_as_float(gw.y & 0xffff0000u);
              u32x2 w; w.x = cvt_pk_bf16(o[i][0] * rs * gg[0] * silu_f(g0), o[i][1] * rs * gg[1] * silu_f(g1));
              w.y = cvt_pk_bf16(o[i][2] * rs * gg[2] * silu_f(g2), o[i][3] * rs * gg[3] * silu_f(g3));
              *(u32x2*)(mr + v0) = w; } }
        }
#pragma unroll
        for (int kb = 0; kb < 8; ++kb) { const f32x4 d4 = *(const LAS f32x4*)(dk + 16 * kb + 4 * fq);
            st[kb] = st[kb] * d4;
            st[kb] = mma16<2>(VT + 16 * wave * SLD, SLD, KsT + 16 * kb * SLD, SLD, st[kb], fr, fq);
            if (FULL) { u32x2 w; w.x = cvt_pk_bf16(st[kb][0], st[kb][1]); w.y = cvt_pk_bf16(st[kb][2], st[kb][3]);
                *(LAS u32x2*)(StT + (16 * wave + fr) * QLD + 16 * kb + 4 * fq) = w; } }
        BLOCK_SYNC();
    }
    if (!FULL) {
        float* So = HS + (size_t)item * 16384 + (16 * wave + fr) * 128 + 4 * fq;
#pragma unroll
        for (int kb = 0; kb < 8; ++kb) *(f32x4*)(So + 16 * kb) = st[kb];
        if (tq == 0) HD[item * 128 + ch] = dsum;
    }
}

__device__ __forceinline__ void lru_pass1(CArgs& a, LAS unsigned char* lds, int layer, int item, const bf16* z, float* LH, float* LP, float* LE) {
    const int tid = opaque_tid(), lane = tid & 63, wave = tid >> 6, fr = lane & 15, fq = lane >> 4;
    const int b = item >> 5, blk = (item >> 3) & 3, sgi = item & 7;
    LAS bf16* WaT = (LAS bf16*)(lds);
    LAS bf16* WxT = (LAS bf16*)(lds + 9216);
    LAS bf16* XC = (LAS bf16*)(lds + 18432);
    LAS float* XCf = (LAS float*)(lds + 27648);
    LAS float* Af = (LAS float*)(lds + 44032);
    LAS float* Uf = (LAS float*)(lds + 60416);
    LAS float* segP = (LAS float*)(lds + 76800);
    LAS float* segH = (LAS float*)(lds + 78848);
    LAS float* carry = (LAS float*)(lds + 80896);
    const int cbase = blk * 64;
    { const float* wa = a.in[I_WA] + ((size_t)layer * 4 + blk) * 4096; const float* wx = a.in[I_WX] + ((size_t)layer * 4 + blk) * 4096;
      for (int e = tid; e < 4096; e += NTHREADS) { const int i = e >> 6, j = e & 63; WaT[j * SLD + i] = f2bf(wa[e]); WxT[j * SLD + i] = f2bf(wx[e]); } }
    if (tid < 64) { carry[tid] = 0.f; carry[64 + tid] = 1.f; }
    const int ct = tid >> 3, c8 = (tid & 7) * 8;
    float cw[4][8], cb[8];
#pragma unroll
    for (int k = 0; k < 8; ++k) { cb[k] = a.in[I_CB][layer * 256 + cbase + c8 + k];
#pragma unroll
        for (int tap = 0; tap < 4; ++tap) cw[tap][k] = a.in[I_CW][(layer * 4 + tap) * 256 + cbase + c8 + k]; }
    const int tb = wave & 3, jh = wave >> 2;
    float gba[2][4], gbx[2][4], gsp[2][4];
#pragma unroll
    for (int i = 0; i < 2; ++i)
#pragma unroll
        for (int j = 0; j < 4; ++j) { const int col = 16 * (jh * 2 + i) + 4 * fq + j;
            gba[i][j] = a.in[I_BA][layer * 256 + cbase + col]; gbx[i][j] = a.in[I_BX][layer * 256 + cbase + col];
            const float lam = a.in[I_LAM][layer * 256 + cbase + col]; gsp[i][j] = log1pf(__expf(-lam)); }
    const int tl0 = sgi * 512;
    u32x4 xv[4];
#pragma unroll
    for (int tap = 0; tap < 4; ++tap) { const int tt = tl0 + ct + tap - 3; xv[tap] = (u32x4){0u, 0u, 0u, 0u};
        if (tt >= 0) xv[tap] = *(const u32x4*)(z + ((size_t)b * SEQ + tt) * DIN + ZX + cbase + c8); }
    BLOCK_SYNC();
    for (int c = 0; c < 8; ++c) {
        const size_t t0 = (size_t)b * SEQ + tl0 + c * 64;
        { float xc[8];
#pragma unroll
          for (int k = 0; k < 8; ++k) xc[k] = cb[k];
#pragma unroll
          for (int tap = 0; tap < 4; ++tap)
#pragma unroll
              for (int k = 0; k < 4; ++k) { xc[2 * k] += cw[tap][2 * k] * __uint_as_float(xv[tap][k] << 16); xc[2 * k + 1] += cw[tap][2 * k + 1] * __uint_as_float(xv[tap][k] & 0xffff0000u); }
          u32x4 w; w.x = cvt_pk_bf16(xc[0], xc[1]); w.y = cvt_pk_bf16(xc[2], xc[3]); w.z = cvt_pk_bf16(xc[4], xc[5]); w.w = cvt_pk_bf16(xc[6], xc[7]);
          *(LAS u32x4*)(XC + ct * SLD + c8) = w;
          *(LAS f32x4*)(XCf + ct * 64 + c8) = (f32x4){xc[0], xc[1], xc[2], xc[3]}; *(LAS f32x4*)(XCf + ct * 64 + c8 + 4) = (f32x4){xc[4], xc[5], xc[6], xc[7]}; }
        if (c + 1 < 8) {
#pragma unroll
            for (int tap = 0; tap < 4; ++tap) xv[tap] = *(const u32x4*)(z + (t0 + 64 + ct + tap - 3) * DIN + ZX + cbase + c8); }
        BLOCK_SYNC();
#pragma unroll
        for (int i = 0; i < 2; ++i) { const int jb = jh * 2 + i; const f32x4 zero = (f32x4){0.f, 0.f, 0.f, 0.f};
            const f32x4 ga = mma16<2>(XC + 16 * tb * SLD, SLD, WaT + 16 * jb * SLD, SLD, zero, fr, fq);
            const f32x4 gx = mma16<2>(XC + 16 * tb * SLD, SLD, WxT + 16 * jb * SLD, SLD, zero, fr, fq);
            const int t = 16 * tb + fr, col0 = 16 * jb + 4 * fq;
            const f32x4 xcv = *(const LAS f32x4*)(XCf + t * 64 + col0);
            f32x4 av, uv;
#pragma unroll
            for (int j = 0; j < 4; ++j) { const float r = fsigmoid(ga[j] + gba[i][j]), gi = fsigmoid(gx[j] + gbx[i][j]);
                const float la = -8.0f * r * gsp[i][j]; av[j] = __expf(la); uv[j] = __builtin_amdgcn_sqrtf(fmaxf(1.f - av[j] * av[j], 0.f)) * gi * xcv[j]; }
            *(LAS f32x4*)(Af + t * 64 + col0) = av; *(LAS f32x4*)(Uf + t * 64 + col0) = uv; }
        BLOCK_SYNC();
        { float av[8], uv[8]; float P = 1.f, H = 0.f;
#pragma unroll
          for (int k = 0; k < 8; ++k) { av[k] = Af[(wave * 8 + k) * 64 + lane]; uv[k] = Uf[(wave * 8 + k) * 64 + lane]; H = av[k] * H + uv[k]; P *= av[k]; }
          segP[wave * 64 + lane] = P; segH[wave * 64 + lane] = H;
          BLOCK_SYNC();
          float h = carry[lane], p = carry[64 + lane];
          for (int q = 0; q < wave; ++q) { const float sp = segP[q * 64 + lane]; h = sp * h + segH[q * 64 + lane]; p *= sp; }
          float* lh = LH + (t0 + wave * 8) * 256 + cbase + lane; float* lp = LP + (t0 + wave * 8) * 256 + cbase + lane;
#pragma unroll
          for (int k = 0; k < 8; ++k) { h = av[k] * h + uv[k]; p *= av[k]; lh[k * 256] = h; lp[k * 256] = p; }
          BLOCK_SYNC();
          if (wave == 7) { carry[lane] = h; carry[64 + lane] = p; } }
    }
    BLOCK_SYNC();
    if (tid < 64) { LE[item * 128 + tid] = carry[64 + tid]; LE[item * 128 + 64 + tid] = carry[tid]; }
    BLOCK_SYNC();
}
__device__ __forceinline__ void lru_pass2(CArgs& a, int layer, int bx, const bf16* z, bf16* mix, const float* LH, const float* LP, const float* LE) {
    const int tid = opaque_tid();
    const int b = bx >> 5, sgi = (bx >> 2) & 7;
    const int tl = tid >> 3, c8 = (tid & 7) * 8;
#pragma unroll 1
    for (int blk = 0; blk < 4; ++blk) {
        float cin[8];
#pragma unroll
        for (int k = 0; k < 8; ++k) cin[k] = 0.f;
        for (int j = 0; j < sgi; ++j) { const float* le = LE + (size_t)((b * 4 + blk) * 8 + j) * 128 + c8;
            const f32x4 p0 = *(const f32x4*)le, p1 = *(const f32x4*)(le + 4), h0 = *(const f32x4*)(le + 64), h1 = *(const f32x4*)(le + 68);
#pragma unroll
            for (int k = 0; k < 4; ++k) { cin[k] = p0[k] * cin[k] + h0[k]; cin[4 + k] = p1[k] * cin[4 + k] + h1[k]; } }
        const float* ng = a.in[I_LN] + layer * 256 + blk * 64 + c8;
        const f32x4 g0 = *(const f32x4*)ng, g1 = *(const f32x4*)(ng + 4);
#pragma unroll
        for (int hh = 0; hh < 2; ++hh) { const size_t t = (size_t)bx * 128 + hh * 64 + tl;
            const float* lh = LH + t * 256 + blk * 64 + c8; const float* lp = LP + t * 256 + blk * 64 + c8;
            const f32x4 h0 = *(const f32x4*)lh, h1 = *(const f32x4*)(lh + 4), p0 = *(const f32x4*)lp, p1 = *(const f32x4*)(lp + 4);
            const u32x4 gv = *(const u32x4*)(z + t * DIN + ZGATE + blk * 64 + c8);
            float y[8]; float ss = 0.f;
#pragma unroll
            for (int k = 0; k < 4; ++k) { const float ge = __uint_as_float(gv[k] << 16), go = __uint_as_float(gv[k] & 0xffff0000u);
                const float he = (k < 2 ? h0[2 * k] : h1[2 * k - 4]) + (k < 2 ? p0[2 * k] : p1[2 * k - 4]) * cin[2 * k];
                const float ho = (k < 2 ? h0[2 * k + 1] : h1[2 * k - 3]) + (k < 2 ? p0[2 * k + 1] : p1[2 * k - 3]) * cin[2 * k + 1];
                y[2 * k] = he * gelu_t(ge); y[2 * k + 1] = ho * gelu_t(go); ss += y[2 * k] * y[2 * k] + y[2 * k + 1] * y[2 * k + 1]; }
            ss += __shfl_xor(ss, 1); ss += __shfl_xor(ss, 2); ss += __shfl_xor(ss, 4);
            const float rs = rsqrtf(ss * (1.f / 64.f) + EPS);
            u32x4 w; w.x = cvt_pk_bf16(y[0] * rs * g0[0], y[1] * rs * g0[1]); w.y = cvt_pk_bf16(y[2] * rs * g0[2], y[3] * rs * g0[3]);
            w.z = cvt_pk_bf16(y[4] * rs * g1[0], y[5] * rs * g1[1]); w.w = cvt_pk_bf16(y[6] * rs * g1[2], y[7] * rs * g1[3]);
            *(u32x4*)(mix + t * D + 512 + blk * 64 + c8) = w; }
    }
}

__device__ __forceinline__ void sgu_items(CArgs& a, LAS unsigned char* lds, int layer, int first, int stride, const bf16* z, bf16* mix) {
    const int tid = opaque_tid(), lane = tid & 63, wave = tid >> 6, fr = lane & 15, fq = lane >> 4;
    LAS bf16* Wm = (LAS bf16*)(lds);
    LAS bf16* VnT = (LAS bf16*)(lds + 34816);
    int cur_grp = -1;
    for (int it = first; it < BATCH * 32 * 4; it += stride) {
        const int grp = it & 3, bn = it >> 2; const size_t t0 = (size_t)bn * 128;
        if (grp != cur_grp) { cur_grp = grp;
            const float* ws = a.in[I_SW] + ((size_t)layer * 4 + grp) * 16384;
            for (int e = tid; e < 4096; e += NTHREADS) { const int t = e >> 5, s0 = (e & 31) * 4; const f32x4 wv = *(const f32x4*)(ws + t * 128 + s0);
                u32x2 w; w.x = cvt_pk_bf16(s0 <= t ? wv[0] : 0.f, s0 + 1 <= t ? wv[1] : 0.f); w.y = cvt_pk_bf16(s0 + 2 <= t ? wv[2] : 0.f, s0 + 3 <= t ? wv[3] : 0.f);
                *(LAS u32x2*)(Wm + t * QLD + s0) = w; } }
        { const int s = tid >> 2, cq = tid & 3; const bf16* vr = z + (t0 + s) * DIN + ZV + grp * 64 + cq * 16;
          const u32x4 r0 = *(const u32x4*)vr, r1 = *(const u32x4*)(vr + 8);
          float v[16]; float sum = 0.f;
#pragma unroll
          for (int k = 0; k < 4; ++k) { v[2 * k] = gelu_t(__uint_as_float(r0[k] << 16)); v[2 * k + 1] = gelu_t(__uint_as_float(r0[k] & 0xffff0000u));
              v[8 + 2 * k] = gelu_t(__uint_as_float(r1[k] << 16)); v[8 + 2 * k + 1] = gelu_t(__uint_as_float(r1[k] & 0xffff0000u)); }
#pragma unroll
          for (int k = 0; k < 16; ++k) sum += v[k];
          sum += __shfl_xor(sum, 1); sum += __shfl_xor(sum, 2);
          const float mu = sum * (1.f / 64.f); float sq = 0.f;
#pragma unroll
          for (int k = 0; k < 16; ++k) { v[k] -= mu; sq += v[k] * v[k]; }
          sq += __shfl_xor(sq, 1); sq += __shfl_xor(sq, 2);
          const float rs = rsqrtf(sq * (1.f / 64.f) + EPS);
#pragma unroll
          for (int k = 0; k < 16; ++k) VnT[(cq * 16 + k) * QLD + s] = f2bf(v[k] * rs); }
        BLOCK_SYNC();
        { const int t = 16 * wave + fr; f32x4 y[4]; float ss = 0.f;
          const float bias = a.in[I_SB][((size_t)layer * 4 + grp) * 128 + t];
          const bf16* ur = z + (t0 + t) * DIN + ZU + grp * 64;
#pragma unroll
          for (int cb = 0; cb < 4; ++cb) { f32x4 acc = (f32x4){0.f, 0.f, 0.f, 0.f};
              acc = mma16<4>(Wm + 16 * wave * QLD, QLD, VnT + 16 * cb * QLD, QLD, acc, fr, fq);
              const u32x2 uw = *(const u32x2*)(ur + 16 * cb + 4 * fq);
              const float u0 = __uint_as_float(uw.x << 16), u1 = __uint_as_float(uw.x & 0xffff0000u), u2 = __uint_as_float(uw.y << 16), u3 = __uint_as_float(uw.y & 0xffff0000u);
              y[cb] = (f32x4){gelu_t(u0) * (acc[0] + bias), gelu_t(u1) * (acc[1] + bias), gelu_t(u2) * (acc[2] + bias), gelu_t(u3) * (acc[3] + bias)};
              ss += (y[cb][0] * y[cb][0] + y[cb][1] * y[cb][1]) + (y[cb][2] * y[cb][2] + y[cb][3] * y[cb][3]); }
          ss += __shfl_xor(ss, 16); ss += __shfl_xor(ss, 32);
          const float rs = SG_SCALE * rsqrtf(ss * (1.f / 64.f) + EPS);
          const float* ng = a.in[I_SN] + layer * 256 + grp * 64; bf16* mr = mix + (t0 + t) * D + 768 + grp * 64;
#pragma unroll
          for (int cb = 0; cb < 4; ++cb) { const f32x4 gg = *(const f32x4*)(ng + 16 * cb + 4 * fq);
              u32x2 w; w.x = cvt_pk_bf16(y[cb][0] * rs * gg[0], y[cb][1] * rs * gg[1]); w.y = cvt_pk_bf16(y[cb][2] * rs * gg[2], y[cb][3] * rs * gg[3]);
              *(u32x2*)(mr + 16 * cb + 4 * fq) = w; } }
        BLOCK_SYNC();
    }
}

#define XB_TMO      128
#define XB_XCNT(j)  (256  + 64 * (j))
#define XB_XSUB(j)  (1280 + 64 * (j))
#define XB_XGEN(j)  (2304 + 64 * (j))
#define XB_TOP      3328
#define XB_TOPGEN   3392
#define XCD_BAR_WORDS 3456
#define XB_SPIN_CAP (1u << 18)

__device__ __forceinline__ unsigned xb_ld(unsigned* p)              { return __hip_atomic_load(p, __ATOMIC_RELAXED, __HIP_MEMORY_SCOPE_AGENT); }
__device__ __forceinline__ unsigned xb_add(unsigned* p, unsigned v) { return __hip_atomic_fetch_add(p, v, __ATOMIC_RELAXED, __HIP_MEMORY_SCOPE_AGENT); }
__device__ __forceinline__ unsigned xb_xcc_id() { return (unsigned)__builtin_amdgcn_s_getreg((3 << 11) | 20) & 0xFu; }
#define XB_SPIN(cond, bar) do { unsigned _sp = 0; while (cond) { __builtin_amdgcn_s_sleep(1); \
    if ((++_sp & 255u) == 0u) { if (xb_ld(&(bar)[XB_TMO])) break; if (_sp > XB_SPIN_CAP) { atomicAdd(&(bar)[XB_TMO], 1u); break; } } } } while (0)

struct XcdBarrier {
    unsigned* bar; unsigned x;
    volatile LAS unsigned* st;
};

__device__ __forceinline__ XcdBarrier xcd_barrier_post(unsigned* bar, volatile LAS unsigned* st) {
    XcdBarrier b; b.bar = bar; b.x = xb_xcc_id(); b.st = st;
    if (threadIdx.x == 0) (void)xb_add(&bar[XB_XCNT(b.x)], 1u);
    return b;
}
__device__ __forceinline__ void xcd_barrier_complete(unsigned* bar, unsigned x, unsigned& nloc, unsigned& nx) {
    const unsigned G = gridDim.x * gridDim.y * gridDim.z;
    unsigned sum, cnt, mine, sp = 0u;
    for (;;) {
        sum = 0u; cnt = 0u; mine = 0u;
#pragma unroll
        for (unsigned j = 0; j < 16; ++j) { const unsigned c = xb_ld(&bar[XB_XCNT(j)]); sum += c; cnt += (c > 0u) ? 1u : 0u; mine = (j == x) ? c : mine; }
        if (sum == G) break;
        __builtin_amdgcn_s_sleep(1);
        if ((++sp & 255u) == 0u) { if (xb_ld(&bar[XB_TMO])) break; if (sp > XB_SPIN_CAP) { atomicAdd(&bar[XB_TMO], 1u); break; } }
    }
    nloc = mine > 0u ? mine : 1u; nx = cnt > 0u ? cnt : 1u;
}

__device__ __forceinline__ void xcd_barrier(const XcdBarrier& b) {
    asm volatile("s_waitcnt vmcnt(0)" ::: "memory");
    __syncthreads();
    if (threadIdx.x == 0) {
        unsigned* bar = b.bar;
        __builtin_amdgcn_s_waitcnt(0);
        unsigned nloc = b.st[0], nx = b.st[1];
        if (nloc == 0u) { xcd_barrier_complete(bar, b.x, nloc, nx); b.st[0] = nloc; b.st[1] = nx; }
        const unsigned old = xb_add(&bar[XB_XSUB(b.x)], 1u);
        const unsigned gen = old / nloc;
        if (old + 1u == (gen + 1u) * nloc) {
            __builtin_amdgcn_fence(__ATOMIC_RELEASE, "agent");
            asm volatile("s_waitcnt vmcnt(0)" ::: "memory");
            const unsigned og = xb_add(&bar[XB_TOP], 1u);
            const unsigned tg = og / nx;
            if (og + 1u == (tg + 1u) * nx) xb_add(&bar[XB_TOPGEN], 1u);
            else XB_SPIN(xb_ld(&bar[XB_TOPGEN]) == tg, bar);
            __builtin_amdgcn_fence(__ATOMIC_ACQUIRE, "agent");
            xb_add(&bar[XB_XGEN(b.x)], 1u);
            asm volatile("s_waitcnt vmcnt(0)" ::: "memory");
        } else {
            XB_SPIN(xb_ld(&bar[XB_XGEN(b.x)]) == gen, bar);
            __builtin_amdgcn_fence(__ATOMIC_ACQUIRE, "agent");
            asm volatile("s_waitcnt vmcnt(0)" ::: "memory");
        }
    }
    __syncthreads();
}

template <class Epi, int ID>
__device__ __forceinline__ void run_gemm(LAS unsigned char* lds, const bf16* A, const bf16* Bt, int N, int K, int G, int bx, const Epi& E) {
#ifndef NO_GEMM
    if (ID & GEMM_MASK) return;
    pg8::Gemm g{A, Bt, T, N, K}; pg8::StaticOrder S; S.init(T, N, G, bx);
    pg8::gemm_phase<Epi, pg8::StaticOrder, true, true>(lds, g, S, E);
#endif
}
__device__ __forceinline__ CArgs* args_ptr() { CArgs* p = (CArgs*)__builtin_amdgcn_kernarg_segment_ptr(); asm volatile("" : "+s"(p)); return p; }
__global__ void __launch_bounds__(NTHREADS, 2) fwd_kernel(Args a_unused) {
    extern __shared__ __attribute__((aligned(16))) unsigned char lds_raw[];
    LAS unsigned char* lds = (LAS unsigned char*)lds_raw;
    cg::grid_group grid = cg::this_grid();
    volatile LAS unsigned* MISC = (volatile LAS unsigned*)(lds + 131072 + 320);
    if (threadIdx.x < 32) MISC[threadIdx.x] = 0u;
    __syncthreads();
    (void)xcd_barrier_post((unsigned*)args_ptr()->ws, MISC + 8);
#define GRID_BAR() do { XcdBarrier b_; b_.bar = (unsigned*)args_ptr()->ws; b_.x = xb_xcc_id(); b_.st = (volatile LAS unsigned*)(lds + 131072 + 320) + 8; xcd_barrier(b_); } while (0)
    const int tid = threadIdx.x, lane = tid & 63, wave = __builtin_amdgcn_readfirstlane(tid >> 6);
    const int G = gridDim.x, bx = blockIdx.x;
    const int gw = bx * NWAVES + wave, NGW = G * NWAVES;
    { CArgs& a = *args_ptr();
      convert_weights(a, lds, gw, NGW, wave, lane);
      norm_rows<false>(a.in[I_X], nullptr, 0.f, nullptr, a.in[I_F1N], (bf16*)(a.ws + WS_XN), nullptr, gw, NGW, lane); }
    grid.sync();
    GRID_BAR();
    constexpr int NPH = 11;
#pragma nounroll
    for (int ph = 0; ph < DEPTH * NPH; ++ph) {
        const int layer = ph / NPH, p = ph - layer * NPH;
        CArgs& a = *args_ptr();
        float* h = a.out; bf16* xn = (bf16*)(a.ws + WS_XN); bf16* mix = xn; bf16* zb = (bf16*)(a.ws + WS_Z); bf16* act = zb;
        const bf16* wl = (const bf16*)(a.ws + WS_W + (size_t)layer * W_LAYER);
        if (p == 0 || p == 8) {
            run_gemm<pg8::EpiSwiGLU, 1>(lds, xn, wl + (p == 0 ? OFF_GU1 : OFF_GU2) / 2, 2 * FF, D, G, bx, pg8::EpiSwiGLU{act, FF});
        } else if (p == 1 || p == 9 || p == 3 || p == 6) {
            const bool dn = (p == 1 || p == 9);
            const bf16* A = dn ? act : xn; const size_t wo = (p == 1) ? OFF_D1 : (p == 9) ? OFF_D2 : (p == 3) ? OFF_IN : OFF_OUT;
            const int N = (p == 3) ? DIN : D, K = dn ? FF : D; bf16* O = dn ? xn : zb;
            run_gemm<pg8::EpiStoreBf16, 4>(lds, A, wl + wo / 2, N, K, G, bx, pg8::EpiStoreBf16{O, N});
        } else if (p == 4) {
            float* HS = (float*)(a.ws + WS_HS); float* HD = (float*)(a.ws + WS_HD);
            for (int it = bx; it < 256; it += G) if ((it & 7) != 7) hgrn_seg<false>(a, lds, layer, it, zb, mix, HS, HD);
            for (int it = bx; it < 256; it += G) lru_pass1(a, lds, layer, it, zb, (float*)(a.ws + WS_LH), (float*)(a.ws + WS_LP), (float*)(a.ws + WS_LE));
            sgu_items(a, lds, layer, bx, G, zb, mix);
        } else if (p == 5) {
            float* HS = (float*)(a.ws + WS_HS); float* HD = (float*)(a.ws + WS_HD);
            for (int it = bx; it < 256; it += G) hgrn_seg<true>(a, lds, layer, it, zb, mix, HS, HD);
            for (int it = bx; it < 256; it += G) lru_pass2(a, layer, it, zb, mix, (const float*)(a.ws + WS_LH), (const float*)(a.ws + WS_LP), (const float*)(a.ws + WS_LE));
        } else {
            const bf16* y = (p == 7) ? zb : xn; const float ys = (p == 7) ? 1.0f : 0.5f; const int lane = opaque_tid() & 63;
            if (p == 10 && layer == DEPTH - 1) norm_rows<true>(h, y, ys, nullptr, a.in[I_FN], nullptr, a.out, gw, NGW, lane);
            else { const float* gain = (p == 2) ? a.in[I_MIXN] + layer * D : (p == 7) ? a.in[I_F2N] + layer * D : a.in[I_F1N] + (layer + 1) * D;
                norm_rows<false>((ph == 2) ? a.in[I_X] : h, y, ys, h, gain, xn, nullptr, gw, NGW, lane); }
        }
        if (ph + 1 < DEPTH * NPH) GRID_BAR();
    }
}

extern "C" void kernel_launch(void* const* d_in, const int* in_sizes, int n_in, void* d_out, int out_size, void* d_ws, size_t ws_size, hipStream_t stream) {
    static int grid = 0;
    if (grid == 0) {
        if (n_in != 26 || in_sizes[0] != T * D || out_size != T * D || ws_size < WS_END) {
            fprintf(stderr, "kernel_launch: unexpected shapes: n_in %d in0 %d out %d ws %zu (need %zu)\n", n_in, n_in > 0 ? in_sizes[0] : -1, out_size, ws_size, (size_t)WS_END); grid = -1; return; }
        int dev = 0, cus = 0, per_cu = 0;
        (void)hipGetDevice(&dev); (void)hipDeviceGetAttribute(&cus, hipDeviceAttributeMultiprocessorCount, dev);
        if (hipFuncSetAttribute((const void*)fwd_kernel, hipFuncAttributeMaxDynamicSharedMemorySize, LDS_BYTES) != hipSuccess) { fprintf(stderr, "kernel_launch: hipFuncSetAttribute failed\n"); grid = -1; return; }
        if (hipOccupancyMaxActiveBlocksPerMultiprocessor(&per_cu, (const void*)fwd_kernel, NTHREADS, LDS_BYTES) != hipSuccess || per_cu < 1) { fprintf(stderr, "kernel_launch: occupancy query gave %d\n", per_cu); per_cu = 1; }
        (void)hipGetLastError();
        grid = cus * per_cu;
        if (grid < 128) { fprintf(stderr, "kernel_launch: grid %d too small\n", grid); grid = -1; return; }
    }
    if (grid < 0) return;
    if (hipMemsetAsync(d_ws, 0, 65536, stream) != hipSuccess) { fprintf(stderr, "kernel_launch: memset failed\n"); return; }
    Args a{};
    for (int i = 0; i < 26; ++i) a.in[i] = (const float*)d_in[i];
    a.out = (float*)d_out; a.ws = (unsigned char*)d_ws;
    void* args[] = {&a};
    hipError_t e = hipLaunchCooperativeKernel((const void*)fwd_kernel, dim3(grid), dim3(NTHREADS), args, LDS_BYTES, stream);
    if (e != hipSuccess) fprintf(stderr, "kernel_launch: cooperative launch failed: %s (grid %d)\n", hipGetErrorString(e), grid);
}
```

```cpp
#include <hip/hip_runtime.h>
#include <hip/hip_cooperative_groups.h>
#include <cstdio>
#include <cstdint>
namespace cg = cooperative_groups;
namespace pg8 {
#define PG8_LAS __attribute__((address_space(3)))
typedef unsigned short bf16_t;
typedef short bf16x8 __attribute__((ext_vector_type(8)));
typedef float f32x4 __attribute__((ext_vector_type(4)));
typedef unsigned u32x4 __attribute__((ext_vector_type(4)));
constexpr int BM = 256, BK = 64, HALF = 128, HTB = HALF * BK * 2  , STAGE_BYTES = 8 * HTB, NXCD = 8, WGM = 8;

__host__ __device__ __forceinline__ int lds_byte(int r, int c) { const int st = (r >> 4) * 2 + (c >> 5), rr = r & 15, cc = c & 31, ob = rr * 64 + cc * 2; return st * 1024 + (ob ^ (((ob >> 9) & 1) << 5)); }
__host__ __device__ __forceinline__ void stage_rc(int b, int& R, int& C) { const int st = b / 1024, sb = b % 1024, swz = sb ^ (((sb >> 9) & 1) << 5); R = (st >> 1) * 16 + swz / 64; C = (st & 1) * 32 + (swz % 64) / 2; }
__host__ __device__ __forceinline__ int perm32(int rho) { const int n = rho >> 4, i = rho & 15; return 8 * (i >> 2) + 4 * n + (i & 3); }

struct Unit { int pm, pn; };
struct Gemm { const bf16_t* A; const bf16_t* Bt; int M, N, K; };

struct StaticOrder {
    int nM, nN, nwg, G, c;
    __host__ __device__ void init(int M, int N, int G_, int c_) { nM = M / BM; nN = N / BM; nwg = nM * nN; G = G_; c = c_; }
    __host__ __device__ bool next(int i, Unit& u) const {
        const long L = (long)i * G + c; if (L >= nwg) return false;
        int wgid = (int)L; { const int q = nwg / NXCD, r = nwg % NXCD, xcd = wgid % NXCD, off = wgid / NXCD; wgid = (xcd < r ? xcd * (q + 1) : r * (q + 1) + (xcd - r) * q) + off; }
        const int nig = WGM * nN, gid = wgid / nig, fm = gid * WGM, gsz = (nM - fm) < WGM ? (nM - fm) : WGM;
        u.pm = fm + ((wgid % nig) % gsz); u.pn = (wgid % nig) / gsz; return true;
    }
    __device__ __forceinline__ void a_ready(const Unit&) const {}
    __device__ __forceinline__ void done(const Unit&) const {}
};

typedef __bf16 bf16x2_t __attribute__((ext_vector_type(2)));
typedef float f32x2_t __attribute__((ext_vector_type(2)));
__device__ __forceinline__ unsigned cvt_pk_bf16(float lo, float hi) { f32x2_t v = {lo, hi}; bf16x2_t b = __builtin_convertvector(v, bf16x2_t); return __builtin_bit_cast(unsigned, b); }
__device__ __forceinline__ float fsigmoid(float x) { return __builtin_amdgcn_rcpf(1.0f + __expf(-x)); }
struct EpiSwiGLU {
    static constexpr bool PERM = true, AFTER_DRAIN = false;
    bf16_t* O; int ldc;
    __device__ __forceinline__ void operator()(const f32x4 (&acc)[2][2][4][2], const Unit& u, int wr, int wc, int fr, int fq) const {
        const int row0 = u.pm * BM + wr * 64 + fr, col0 = u.pn * HALF + wc * 32 + 8 * fq;
#pragma unroll
        for (int ai = 0; ai < 2; ++ai)
#pragma unroll
            for (int m = 0; m < 4; ++m) { bf16_t* rowp = O + (size_t)(row0 + ai * HALF + m * 16) * ldc + col0;
                float v[8];
#pragma unroll
                for (int n = 0; n < 2; ++n)
#pragma unroll
                    for (int j = 0; j < 4; ++j) { const float g = acc[ai][0][m][n][j], up = acc[ai][1][m][n][j]; v[n * 4 + j] = g * fsigmoid(g) * up; }
                u32x4 w; w.x = cvt_pk_bf16(v[0], v[1]); w.y = cvt_pk_bf16(v[2], v[3]); w.z = cvt_pk_bf16(v[4], v[5]); w.w = cvt_pk_bf16(v[6], v[7]);
                *(u32x4*)rowp = w; }
    }
};
struct EpiStoreBf16 {
    static constexpr bool PERM = true, AFTER_DRAIN = false;
    bf16_t* O; int ldc;
    __device__ __forceinline__ void operator()(const f32x4 (&acc)[2][2][4][2], const Unit& u, int wr, int wc, int fr, int fq) const {
        const int row0 = u.pm * BM + wr * 64 + fr, col0 = u.pn * BM + wc * 32 + 8 * fq;
#pragma unroll
        for (int ai = 0; ai < 2; ++ai)
#pragma unroll
            for (int m = 0; m < 4; ++m) { bf16_t* rowp = O + (size_t)(row0 + ai * HALF + m * 16) * ldc + col0;
#pragma unroll
                for (int bj = 0; bj < 2; ++bj) { const f32x4 v0 = acc[ai][bj][m][0], v1 = acc[ai][bj][m][1];
                    u32x4 w; w.x = cvt_pk_bf16(v0[0], v0[1]); w.y = cvt_pk_bf16(v0[2], v0[3]); w.z = cvt_pk_bf16(v1[0], v1[1]); w.w = cvt_pk_bf16(v1[2], v1[3]);
                    *(u32x4*)(rowp + bj * HALF) = w; } }
    }
};
struct EpiResidual {
    static constexpr bool PERM = false, AFTER_DRAIN = false;
    float* H; int ldc; float scale;
    __device__ __forceinline__ void operator()(const f32x4 (&acc)[2][2][4][2], const Unit& u, int wr, int wc, int fr, int fq) const {
        const int col0 = u.pn * BM + wc * 32 + 4 * fq;
#pragma unroll
        for (int ai = 0; ai < 2; ++ai)
#pragma unroll
            for (int m = 0; m < 4; ++m) { float* rowp = H + (size_t)(u.pm * BM + ai * HALF + wr * 64 + m * 16 + fr) * ldc + col0;
#pragma unroll
                for (int bj = 0; bj < 2; ++bj)
#pragma unroll
                    for (int n = 0; n < 2; ++n) { f32x4* p = (f32x4*)(rowp + bj * HALF + n * 16); const f32x4 o = *p + acc[ai][bj][m][n] * scale; *p = o; }
                asm volatile("" ::: "memory"); }
    }
};
template <class Epi, class Sched, bool ALIGN_EPI = false, bool SP2 = false>
__device__ __forceinline__ void gemm_phase(PG8_LAS unsigned char* lds, const Gemm g, const Sched& S, const Epi& E) {
    const int tid = threadIdx.x, wid = __builtin_amdgcn_readfirstlane(tid >> 6), lane = tid & 63, wr = wid >> 2, wc = wid & 3, fr = lane & 15, fq = lane >> 4;
    const int K = g.K, nt = K / BK;
    unsigned voffA[2], voffB[2];
#pragma unroll
    for (int i = 0; i < 2; ++i) { int R, C; stage_rc(tid * 16 + i * 8192, R, C); const int Rb = Epi::PERM ? ((R & ~31) + perm32(R & 31)) : R;
        voffA[i] = (unsigned)(R * K + C) * 2u; voffB[i] = (unsigned)(Rb * K + C) * 2u; }
    const size_t kstep = (size_t)(BK * 2);
    const size_t hstep = (size_t)HALF * K * 2;
    const size_t tstep = 2 * hstep;
    const unsigned ldsw = (unsigned)wid * 1024u;
    const int aoff = lds_byte(wr * 64 + fr, fq * 8), boff = lds_byte(wc * 32 + fr, fq * 8);
#define PG8_SA(b, h) (((b) * 2 + (h)) * HTB)
#define PG8_SB(b, h) ((4 + (b) * 2 + (h)) * HTB)
#define PG8_STAGE(bufoff, gbase, voff) do { _Pragma("unroll") for (int _i = 0; _i < 2; ++_i) \
        __builtin_amdgcn_global_load_lds((const unsigned*)((const char*)(gbase) + (voff)[_i]), (PG8_LAS unsigned*)(lds + (bufoff) + ldsw + _i * 8192), 16, 0, 0); } while (0)
#define PG8_LDA(dst, b, h) do { _Pragma("unroll") for (int m = 0; m < 4; ++m) _Pragma("unroll") for (int k = 0; k < 2; ++k) dst[m][k] = *(const PG8_LAS bf16x8*)(lds + PG8_SA(b, h) + aoff + m * 2048 + k * 1024); } while (0)
#define PG8_LDB(dst, b, h) do { _Pragma("unroll") for (int n = 0; n < 2; ++n) _Pragma("unroll") for (int k = 0; k < 2; ++k) dst[n][k] = *(const PG8_LAS bf16x8*)(lds + PG8_SB(b, h) + boff + n * 2048 + k * 1024); } while (0)
#define PG8_MMA(ai, bj, At, Bt) do { __builtin_amdgcn_s_setprio(1); _Pragma("unroll") for (int m = 0; m < 4; ++m) _Pragma("unroll") for (int n = 0; n < 2; ++n) _Pragma("unroll") for (int k = 0; k < 2; ++k) \
        acc[ai][bj][m][n] = __builtin_amdgcn_mfma_f32_16x16x32_bf16(Bt[n][k], At[m][k], acc[ai][bj][m][n], 0, 0, 0); __builtin_amdgcn_s_setprio(0); } while (0)
#define PG8_WAIT_V(n) asm volatile("s_waitcnt vmcnt(" #n ")" ::: "memory")
#define PG8_WAIT_L(n) asm volatile("s_waitcnt lgkmcnt(" #n ")" ::: "memory")
#define PG8_BAR __builtin_amdgcn_s_barrier()
#define PG8_SCHED __builtin_amdgcn_sched_barrier(0)
    Unit cur, nxt; int ui = 0;
    if (!S.next(0, cur)) return;
    f32x4 acc[2][2][4][2];
#pragma unroll
    for (int a = 0; a < 2; ++a)
#pragma unroll
        for (int b = 0; b < 2; ++b)
#pragma unroll
            for (int m = 0; m < 4; ++m)
#pragma unroll
                for (int n = 0; n < 2; ++n) acc[a][b][m][n] = (f32x4){0.f, 0.f, 0.f, 0.f};
    bf16x8 At[4][2], B0[2][2], B1[2][2];
    const char* cA = (const char*)g.A + (size_t)cur.pm * tstep; const char* cB = (const char*)g.Bt + (size_t)cur.pn * tstep;
    S.a_ready(cur);
    if constexpr (SP2) {
        PG8_STAGE(PG8_SB(0, 0), cB, voffB); PG8_STAGE(PG8_SB(0, 1), cB + hstep, voffB); PG8_STAGE(PG8_SA(0, 0), cA, voffA); PG8_STAGE(PG8_SA(0, 1), cA + hstep, voffA);
        if (wr == 1) PG8_BAR;
        PG8_WAIT_V(2); PG8_BAR;
        PG8_STAGE(PG8_SB(1, 0), cB + kstep, voffB); PG8_STAGE(PG8_SA(1, 0), cA + kstep, voffA); PG8_STAGE(PG8_SB(1, 1), cB + hstep + kstep, voffB);
        PG8_WAIT_V(6); PG8_BAR;
    } else {
        PG8_STAGE(PG8_SB(0, 0), cB, voffB); PG8_STAGE(PG8_SA(0, 0), cA, voffA); PG8_STAGE(PG8_SB(0, 1), cB + hstep, voffB); PG8_STAGE(PG8_SA(0, 1), cA + hstep, voffA);
        if (wr == 1) PG8_BAR;
        PG8_WAIT_V(4); PG8_BAR;
        PG8_STAGE(PG8_SB(1, 0), cB + kstep, voffB); PG8_STAGE(PG8_SA(1, 0), cA + kstep, voffA); PG8_STAGE(PG8_SB(1, 1), cB + hstep + kstep, voffB);
        PG8_WAIT_V(6); PG8_BAR;
    }
    for (;;) {
        const bool has_next = S.next(ui + 1, nxt);
        const char* nA = has_next ? (const char*)g.A + (size_t)nxt.pm * tstep : cA; const char* nB = has_next ? (const char*)g.Bt + (size_t)nxt.pn * tstep : cB;
        for (int t = 0; t < nt; t += 2) {
            const bool last = (t == nt - 2);
            const char* a1 = cA + (size_t)(t + 1) * kstep;
            const char* a2 = last ? nA : cA + (size_t)(t + 2) * kstep; const char* b2 = last ? nB : cB + (size_t)(t + 2) * kstep;
            const char* a3 = a2 + kstep; const char* b3 = b2 + kstep;
            if (last && has_next) S.a_ready(nxt);
            if constexpr (SP2) {
            PG8_LDB(B0, 0, 0); PG8_LDB(B1, 0, 1); PG8_SCHED; PG8_LDA(At, 0, 0); PG8_STAGE(PG8_SA(1, 1), a1 + hstep, voffA);
            PG8_WAIT_V(8); PG8_WAIT_L(0); PG8_BAR; PG8_MMA(0, 0, At, B0); PG8_MMA(0, 1, At, B1); PG8_BAR; PG8_SCHED;
            PG8_LDA(At, 0, 1); PG8_STAGE(PG8_SB(0, 0), b2, voffB); PG8_STAGE(PG8_SB(0, 1), b2 + hstep, voffB); PG8_STAGE(PG8_SA(0, 0), a2, voffA);
            PG8_WAIT_V(8); PG8_WAIT_L(0); PG8_BAR; PG8_MMA(1, 0, At, B0); PG8_MMA(1, 1, At, B1); PG8_BAR; PG8_SCHED;
            PG8_LDB(B0, 1, 0); PG8_LDB(B1, 1, 1); PG8_SCHED; PG8_LDA(At, 1, 0); PG8_STAGE(PG8_SA(0, 1), a2 + hstep, voffA);
            PG8_WAIT_V(8); PG8_WAIT_L(0); PG8_BAR; PG8_MMA(0, 0, At, B0); PG8_MMA(0, 1, At, B1); PG8_BAR; PG8_SCHED;
            PG8_LDA(At, 1, 1); PG8_STAGE(PG8_SB(1, 0), b3, voffB); PG8_STAGE(PG8_SB(1, 1), b3 + hstep, voffB); PG8_STAGE(PG8_SA(1, 0), a3, voffA);
            PG8_WAIT_V(8); PG8_WAIT_L(0); PG8_BAR; PG8_MMA(1, 0, At, B0); PG8_MMA(1, 1, At, B1); PG8_BAR; PG8_SCHED;
            } else {
            PG8_LDB(B0, 0, 0); PG8_SCHED; PG8_LDA(At, 0, 0); PG8_STAGE(PG8_SA(1, 1), a1 + hstep, voffA);
            PG8_WAIT_L(8); PG8_BAR; PG8_WAIT_L(0); PG8_MMA(0, 0, At, B0); PG8_BAR; PG8_SCHED;
            PG8_LDB(B1, 0, 1); PG8_STAGE(PG8_SB(0, 0), b2, voffB);
            PG8_BAR; PG8_WAIT_L(0); PG8_MMA(0, 1, At, B1); PG8_BAR;
            PG8_LDA(At, 0, 1); PG8_STAGE(PG8_SA(0, 0), a2, voffA);
            PG8_BAR; PG8_WAIT_L(0); PG8_MMA(1, 0, At, B0); PG8_BAR; PG8_SCHED;
            PG8_STAGE(PG8_SB(0, 1), b2 + hstep, voffB);
            PG8_WAIT_V(6); PG8_BAR; PG8_MMA(1, 1, At, B1); PG8_BAR;
            PG8_LDB(B0, 1, 0); PG8_SCHED; PG8_LDA(At, 1, 0); PG8_STAGE(PG8_SA(0, 1), a2 + hstep, voffA);
            PG8_WAIT_L(8); PG8_BAR; PG8_WAIT_L(0); PG8_MMA(0, 0, At, B0); PG8_BAR; PG8_SCHED;
            PG8_LDB(B1, 1, 1); PG8_STAGE(PG8_SB(1, 0), b3, voffB);
            PG8_BAR; PG8_WAIT_L(0); PG8_MMA(0, 1, At, B1); PG8_BAR;
            PG8_LDA(At, 1, 1); PG8_STAGE(PG8_SA(1, 0), a3, voffA);
            PG8_BAR; PG8_WAIT_L(0); PG8_MMA(1, 0, At, B0); PG8_BAR; PG8_SCHED;
            PG8_STAGE(PG8_SB(1, 1), b3 + hstep, voffB);
            PG8_WAIT_V(6); PG8_BAR; PG8_MMA(1, 1, At, B1); PG8_BAR;
            }
        }
        if constexpr (ALIGN_EPI) { if (wr == 0) PG8_BAR; }
        if constexpr (!Epi::AFTER_DRAIN) { E(acc, cur, wr, wc, fr, fq); S.done(cur); }
        if (!has_next) break;
#pragma unroll
        for (int a = 0; a < 2; ++a)
#pragma unroll
            for (int b = 0; b < 2; ++b)
#pragma unroll
                for (int m = 0; m < 4; ++m)
#pragma unroll
                    for (int n = 0; n < 2; ++n) acc[a][b][m][n] = (f32x4){0.f, 0.f, 0.f, 0.f};
        cur = nxt; cA = nA; cB = nB; ++ui;
        if constexpr (ALIGN_EPI) { if (wr == 1) PG8_BAR; }
    }
    PG8_WAIT_V(0);
    if constexpr (!ALIGN_EPI) { if (wr == 0) PG8_BAR; }
    PG8_BAR;
    if constexpr (Epi::AFTER_DRAIN) { E.fused(acc, cur, wr, wc, fr, fq, lds, wid, lane); S.done(cur); }
#undef PG8_SA
#undef PG8_SB
#undef PG8_STAGE
#undef PG8_LDA
#undef PG8_LDB
#undef PG8_MMA
#undef PG8_WAIT_V
#undef PG8_WAIT_L
#undef PG8_BAR
#undef PG8_SCHED
}
}

#define LAS __attribute__((address_space(3)))
typedef unsigned short bf16;
typedef short bf16x8 __attribute__((ext_vector_type(8)));
typedef float f32x4 __attribute__((ext_vector_type(4)));
typedef unsigned u32x4 __attribute__((ext_vector_type(4)));
typedef unsigned u32x2 __attribute__((ext_vector_type(2)));
using pg8::cvt_pk_bf16;
using pg8::fsigmoid;

#ifndef HG_SCALE
#define HG_SCALE 1.0f
#endif
#ifndef LR_SCALE
#define LR_SCALE 1.0f
#endif
#ifndef SG_SCALE
#define SG_SCALE 1.0f
#endif
#ifndef GEMM_MASK
#define GEMM_MASK 0
#endif
constexpr int NWAVES = 8, NTHREADS = 512;
constexpr int DEPTH = 4, BATCH = 8, SEQ = 4096, D = 1024, T = BATCH * SEQ, FF = 2816, DIN = 3072;
constexpr float EPS = 1e-6f;
constexpr int LDS_BYTES = 147456;
constexpr int ZQ = 0, ZF = 512, ZI = 1024, ZG = 1536, ZX = 2048, ZGATE = 2304, ZU = 2560, ZV = 2816;
constexpr size_t MiB = 1u << 20;
constexpr size_t W_GU = (size_t)2 * FF * D * 2, W_D = (size_t)D * FF * 2, W_IN = (size_t)DIN * D * 2, W_OUT = (size_t)D * D * 2;
constexpr size_t OFF_GU1 = 0, OFF_D1 = OFF_GU1 + W_GU, OFF_IN = OFF_D1 + W_D, OFF_OUT = OFF_IN + W_IN, OFF_GU2 = OFF_OUT + W_OUT, OFF_D2 = OFF_GU2 + W_GU, W_LAYER = OFF_D2 + W_D;
constexpr size_t WS_W = 1 * MiB, WS_XN = WS_W + DEPTH * W_LAYER, WS_Z = WS_XN + (size_t)T * D * 2, WS_HS = WS_Z + (size_t)T * DIN * 2, WS_HD = WS_HS + (size_t)256 * 65536, WS_LE = WS_HD + 256 * 512, WS_LH = WS_LE + 256 * 512, WS_LP = WS_LH + (size_t)T * 256 * 4, WS_END = WS_LP + (size_t)T * 256 * 4;

struct Args { const float* in[26]; float* out; unsigned char* ws; };
typedef const Args __attribute__((address_space(4))) CArgs;
enum { I_X = 0, I_F1N, I_F1G, I_F1U, I_F1D, I_MIXN, I_WIN, I_LB, I_HN, I_CW, I_CB, I_WA, I_BA, I_WX, I_BX, I_LAM, I_LN, I_SW, I_SB, I_SN, I_WOUT, I_F2N, I_F2G, I_F2U, I_F2D, I_FN };

__device__ __forceinline__ float bf2f(unsigned short h) { return __uint_as_float((unsigned)h << 16); }
__device__ __forceinline__ unsigned short f2bf(float f) { return (unsigned short)(cvt_pk_bf16(f, 0.f) & 0xffffu); }
__device__ __forceinline__ float gelu_t(float x) { return x * fsigmoid(1.5957691216f * (x + 0.044715f * x * x * x)); }
__device__ __forceinline__ float silu_f(float x) { return x * fsigmoid(x); }
__device__ __forceinline__ float wave_sum(float v) {
#pragma unroll
    for (int o = 1; o < 64; o <<= 1) v += __shfl_xor(v, o);
    return v;
}
#define BLOCK_SYNC() do { asm volatile("s_waitcnt lgkmcnt(0)" ::: "memory"); __builtin_amdgcn_s_barrier(); asm volatile("" ::: "memory"); } while (0)
__device__ __forceinline__ int opaque_tid() { int t = threadIdx.x; asm volatile("" : "+v"(t)); return t; }

struct CvtItem { const float* src; bf16* dst; int K, N, k0, n0, drow0; };
__device__ __forceinline__ CvtItem cvt_item(CArgs& a, int it) {
    constexpr int I_FFU = (D / 128) * (FF / 128), I_FFD = (FF / 128) * (D / 128), I_IN_ = (D / 128) * (DIN / 128), I_OUT_ = (D / 128) * (D / 128);
    constexpr int PER_LAYER = 4 * I_FFU + 2 * I_FFD + I_IN_ + I_OUT_;
    const int layer = it / PER_LAYER; int r = it % PER_LAYER;
    bf16* wl = (bf16*)(a.ws + WS_W + (size_t)layer * W_LAYER);
    CvtItem c; int mode = 0;
    if (r < I_FFU) { c.src = a.in[I_F1G] + (size_t)layer * D * FF; c.K = D; c.N = FF; c.dst = wl + OFF_GU1 / 2; mode = 1; }
    else if ((r -= I_FFU) < I_FFU) { c.src = a.in[I_F1U] + (size_t)layer * D * FF; c.K = D; c.N = FF; c.dst = wl + OFF_GU1 / 2; mode = 2; }
    else if ((r -= I_FFU) < I_FFD) { c.src = a.in[I_F1D] + (size_t)layer * D * FF; c.K = FF; c.N = D; c.dst = wl + OFF_D1 / 2; }
    else if ((r -= I_FFD) < I_IN_) { c.src = a.in[I_WIN] + (size_t)layer * D * DIN; c.K = D; c.N = DIN; c.dst = wl + OFF_IN / 2; }
    else if ((r -= I_IN_) < I_OUT_) { c.src = a.in[I_WOUT] + (size_t)layer * D * D; c.K = D; c.N = D; c.dst = wl + OFF_OUT / 2; }
    else if ((r -= I_OUT_) < I_FFU) { c.src = a.in[I_F2G] + (size_t)layer * D * FF; c.K = D; c.N = FF; c.dst = wl + OFF_GU2 / 2; mode = 1; }
    else if ((r -= I_FFU) < I_FFU) { c.src = a.in[I_F2U] + (size_t)layer * D * FF; c.K = D; c.N = FF; c.dst = wl + OFF_GU2 / 2; mode = 2; }
    else { r -= I_FFU; c.src = a.in[I_F2D] + (size_t)layer * D * FF; c.K = FF; c.N = D; c.dst = wl + OFF_D2 / 2; }
    const int nblk = c.N / 128, kb = r / nblk, nb = r % nblk; c.k0 = 128 * kb; c.n0 = 128 * nb;
    c.drow0 = mode == 0 ? c.n0 : (nb * 256 + (mode == 2 ? 128 : 0));
    return c;
}
__device__ __forceinline__ void convert_weights(CArgs& a, LAS unsigned char* lds, int bx, int G) {
    constexpr int I_FFU = (D / 128) * (FF / 128), I_FFD = (FF / 128) * (D / 128), I_IN_ = (D / 128) * (DIN / 128), I_OUT_ = (D / 128) * (D / 128);
    constexpr int NITEMS = DEPTH * (4 * I_FFU + 2 * I_FFD + I_IN_ + I_OUT_);
    constexpr int TLD = 136;
    LAS bf16* Tt = (LAS bf16*)lds;
    const int t = threadIdx.x, lr = t >> 5, lc = (t & 31) * 4;
    const int sn = t >> 4, sk = (t & 15) * 8;
    const int swz = ((t & 31) & 7) * 8;
    f32x4 v[8];
    int it = bx;
    if (it < NITEMS) { const CvtItem c = cvt_item(a, it);
#pragma unroll
        for (int i = 0; i < 8; ++i) v[i] = *(const f32x4*)(c.src + (size_t)(c.k0 + lr + 16 * i) * c.N + c.n0 + lc); }
    for (; it < NITEMS; it += G) {
        const CvtItem c = cvt_item(a, it);
#pragma unroll
        for (int i = 0; i < 8; ++i) { const int k = lr + 16 * i;
#pragma unroll
            for (int j = 0; j < 4; ++j) Tt[(lc + j) * TLD + (k ^ swz)] = f2bf(v[i][j]); }
        if (it + G < NITEMS) { const CvtItem cn = cvt_item(a, it + G);
#pragma unroll
            for (int i = 0; i < 8; ++i) v[i] = *(const f32x4*)(cn.src + (size_t)(cn.k0 + lr + 16 * i) * cn.N + cn.n0 + lc); }
        BLOCK_SYNC();
#pragma unroll
        for (int i = 0; i < 4; ++i) { const int n = sn + 32 * i; const u32x4 w = *(const LAS u32x4*)(Tt + n * TLD + (sk ^ (((n >> 2) & 7) * 8)));
            *(u32x4*)(c.dst + (size_t)(c.drow0 + n) * c.K + c.k0 + sk) = w; }
        BLOCK_SYNC();
    }
}
template <bool HB, bool FINAL>
__device__ __forceinline__ void norm_rows(const void* src, const bf16* y, float ys, bf16* hdst, const float* gain, bf16* xn, float* fout, float* fstage, int gw, int NGW, int lane) {
    f32x4 gv[4];
#pragma unroll
    for (int j = 0; j < 4; ++j) gv[j] = ((const f32x4*)gain)[lane + 64 * j];
    for (int m0 = gw; m0 < T; m0 += 2 * NGW) {
        f32x4 v[2][4]; u32x2 yw[2][4];
#pragma unroll
        for (int r = 0; r < 2; ++r) { const int m = m0 + r * NGW;
            if (HB) { const u32x2* hr = (const u32x2*)((const bf16*)src + (size_t)m * D) + lane;
#pragma unroll
                for (int j = 0; j < 4; ++j) { const u32x2 w = hr[64 * j]; v[r][j] = (f32x4){__uint_as_float(w.x << 16), __uint_as_float(w.x & 0xffff0000u), __uint_as_float(w.y << 16), __uint_as_float(w.y & 0xffff0000u)}; }
            } else { const f32x4* xr = (const f32x4*)((const float*)src + (size_t)m * D) + lane;
#pragma unroll
                for (int j = 0; j < 4; ++j) v[r][j] = xr[64 * j]; }
            if (y) { const u32x2* yr = (const u32x2*)(y + (size_t)m * D) + lane;
#pragma unroll
                for (int j = 0; j < 4; ++j) yw[r][j] = yr[64 * j]; } }
        float s[2];
#pragma unroll
        for (int r = 0; r < 2; ++r) { s[r] = 0.f;
            if (y) {
#pragma unroll
                for (int j = 0; j < 4; ++j) { const u32x2 w = yw[r][j];
                    v[r][j].x += ys * __uint_as_float(w.x << 16); v[r][j].y += ys * __uint_as_float(w.x & 0xffff0000u); v[r][j].z += ys * __uint_as_float(w.y << 16); v[r][j].w += ys * __uint_as_float(w.y & 0xffff0000u); } }
#pragma unroll
            for (int j = 0; j < 4; ++j) s[r] += (v[r][j].x * v[r][j].x + v[r][j].y * v[r][j].y) + (v[r][j].z * v[r][j].z + v[r][j].w * v[r][j].w); }
#pragma unroll
        for (int o = 1; o < 64; o <<= 1) { s[0] += __shfl_xor(s[0], o); s[1] += __shfl_xor(s[1], o); }
#pragma unroll
        for (int r = 0; r < 2; ++r) { const int m = m0 + r * NGW; const float rstd = rsqrtf(s[r] * (1.f / D) + EPS);
            if (!FINAL && hdst) { u32x2* hr = (u32x2*)(hdst + (size_t)m * D) + lane;
#pragma unroll
                for (int j = 0; j < 4; ++j) { u32x2 w; w.x = cvt_pk_bf16(v[r][j].x, v[r][j].y); w.y = cvt_pk_bf16(v[r][j].z, v[r][j].w); hr[64 * j] = w; } }
            if (FINAL) { f32x4* o = (f32x4*)((m >= T / 2 ? fout : fstage) + (size_t)m * D) + lane;
#pragma unroll
                for (int j = 0; j < 4; ++j) o[64 * j] = v[r][j] * rstd * gv[j];
            } else { u32x2* o = (u32x2*)(xn + (size_t)m * D) + lane;
#pragma unroll
                for (int j = 0; j < 4; ++j) { const f32x4 q = v[r][j] * rstd * gv[j]; u32x2 w; w.x = cvt_pk_bf16(q.x, q.y); w.y = cvt_pk_bf16(q.z, q.w); o[64 * j] = w; } } }
    }
}
__device__ __forceinline__ void copy_rows(const float* st, float* out, int gw, int NGW, int lane) {
    for (int m = gw; m < T / 2; m += NGW) { const f32x4* a = (const f32x4*)(st + (size_t)m * D) + lane; f32x4* o = (f32x4*)(out + (size_t)m * D) + lane;
        f32x4 v[4];
#pragma unroll
        for (int j = 0; j < 4; ++j) v[j] = a[64 * j];
#pragma unroll
        for (int j = 0; j < 4; ++j) o[64 * j] = v[j]; }
}

template <int KSTEPS>
__device__ __forceinline__ f32x4 mma16(const LAS bf16* A, int lda, const LAS bf16* B, int ldb, f32x4 acc, int fr, int fq) {
    const LAS bf16* ap = A + fr * lda + fq * 8; const LAS bf16* bp = B + fr * ldb + fq * 8;
#pragma unroll
    for (int kk = 0; kk < KSTEPS; ++kk) {
        const bf16x8 av = *(const LAS bf16x8*)(ap + kk * 32); const bf16x8 bv = *(const LAS bf16x8*)(bp + kk * 32);
        acc = __builtin_amdgcn_mfma_f32_16x16x32_bf16(bv, av, acc, 0, 0, 0);
    }
    return acc;
}

constexpr int QLD = 136, SLD = 72;
constexpr int NSEG = 8, SEG_CHUNKS = SEQ / 64 / NSEG;
template <bool FULL>
__device__ __forceinline__ void hgrn_seg(CArgs& a, LAS unsigned char* lds, int layer, int item, const bf16* z, bf16* mix, float* HS, float* HD) {
    const int tid = opaque_tid(), lane = tid & 63, wave = tid >> 6, fr = lane & 15, fq = lane >> 4;
    const int b = item >> 5, hd = (item >> 3) & 3, sgi = item & 7;
    LAS bf16* Q = (LAS bf16*)(lds);
    LAS bf16* Kt = (LAS bf16*)(lds + 17408);
    LAS bf16* KsT = (LAS bf16*)(lds + 34816);
    LAS bf16* VT = (LAS bf16*)(lds + 53248);
    LAS bf16* S = (LAS bf16*)(lds + 71680);
    LAS bf16* StT = (LAS bf16*)(lds + 80896);
    LAS float* dk = (LAS float*)(lds + 115712);
    LAS float* seg = (LAS float*)(lds + 116224);
    LAS float* red = (LAS float*)(lds + 118272);
    const int ch = tid & 127, tq = tid >> 7;
    float lb;
    { const float* lg = a.in[I_LB] + hd * 128 + ch; const float l0 = lg[0], l1 = lg[512], l2 = lg[1024], l3 = lg[1536];
      const float mx = fmaxf(fmaxf(l0, l1), fmaxf(l2, l3)); const float e0 = __expf(l0 - mx), e1 = __expf(l1 - mx), e2 = __expf(l2 - mx), e3 = __expf(l3 - mx);
      const float inv = 1.f / (e0 + e1 + e2 + e3); lb = (layer >= 1 ? e1 : 0.f) + (layer >= 2 ? e2 : 0.f) + (layer >= 3 ? e3 : 0.f); lb *= inv; }
    const float oml = 1.f - lb;
    f32x4 st[8];
#pragma unroll
    for (int i = 0; i < 8; ++i) st[i] = (f32x4){0.f, 0.f, 0.f, 0.f};
    if (FULL) {
        for (int j = 0; j < sgi; ++j) { const float* Sj = HS + (size_t)(item - sgi + j) * 16384 + (16 * wave + fr) * 128 + 4 * fq; const float* Dj = HD + (item - sgi + j) * 128 + 4 * fq;
#pragma unroll
            for (int kb = 0; kb < 8; ++kb) st[kb] = st[kb] * *(const f32x4*)(Dj + 16 * kb) + *(const f32x4*)(Sj + 16 * kb); }
#pragma unroll
        for (int kb = 0; kb < 8; ++kb) { u32x2 w; w.x = cvt_pk_bf16(st[kb][0], st[kb][1]); w.y = cvt_pk_bf16(st[kb][2], st[kb][3]);
            *(LAS u32x2*)(StT + (16 * wave + fr) * QLD + 16 * kb + 4 * fq) = w; }
    }
    const int tb = wave & 3, vh = wave >> 2;
    const float* gn = a.in[I_HN] + layer * 512 + hd * 128;
    float dsum = 1.f;
    f32x4 ggv[4];
    if (FULL) {
#pragma unroll
        for (int i = 0; i < 4; ++i) ggv[i] = *(const f32x4*)(gn + 16 * ((wave >> 2) * 4 + i) + 4 * fq); }
    unsigned short rf[16], rq[16], ri[16];
    const size_t tseg = (size_t)b * SEQ + (size_t)sgi * SEG_CHUNKS * 64;
    { const bf16* zr = z + (tseg + tq * 16) * DIN + hd * 128 + ch;
#pragma unroll
      for (int j = 0; j < 16; ++j) { rf[j] = zr[(size_t)j * DIN + ZF]; ri[j] = zr[(size_t)j * DIN + ZI]; if (FULL) rq[j] = zr[(size_t)j * DIN + ZQ]; } }
    BLOCK_SYNC();
    for (int c = 0; c < SEG_CHUNKS; ++c) {
        const size_t t0 = tseg + c * 64;
        float bl[16], kv[16]; float run = 1.f;
#pragma unroll
        for (int j = 0; j < 16; ++j) { const float x = fminf(fmaxf(bf2f(rf[j]), -30.f), 30.f); const float e = __expf(-x), sg = __builtin_amdgcn_rcpf(1.f + e);
            const float f = lb + oml * sg; run *= f; bl[j] = run; kv[j] = oml * e * sg; }
        seg[tq * 128 + ch] = run;
        BLOCK_SYNC();
        float prefix = 1.f, total = 1.f;
#pragma unroll
        for (int q = 0; q < 4; ++q) { const float sv = seg[q * 128 + ch]; total *= sv; if (q < tq) prefix *= sv; }
        dsum *= total;
        unsigned ksp[8], vip[8];
#pragma unroll
        for (int j = 0; j < 16; j += 2) {
            float ks2[2];
#pragma unroll
            for (int jj = 0; jj < 2; ++jj) { const int t = j + jj; const float e1 = fmaxf(prefix * bl[t], 1e-35f), e2 = __builtin_amdgcn_rcpf(e1);
                if (FULL) { const float qx = bf2f(rq[t]); const float qv = qx * fsigmoid(qx);
                    Q[(tq * 16 + t) * QLD + ch] = f2bf(qv * e1);
                    Kt[(tq * 16 + t) * QLD + ch] = f2bf(kv[t] * e2); }
                ks2[jj] = kv[t] * (total * e2); }
            ksp[j >> 1] = cvt_pk_bf16(ks2[0], ks2[1]); vip[j >> 1] = (unsigned)ri[j] | ((unsigned)ri[j + 1] << 16);
        }
        { LAS u32x4* kp = (LAS u32x4*)(KsT + ch * SLD + tq * 16); kp[0] = (u32x4){ksp[0], ksp[1], ksp[2], ksp[3]}; kp[1] = (u32x4){ksp[4], ksp[5], ksp[6], ksp[7]};
          LAS u32x4* vp = (LAS u32x4*)(VT + ch * SLD + tq * 16); vp[0] = (u32x4){vip[0], vip[1], vip[2], vip[3]}; vp[1] = (u32x4){vip[4], vip[5], vip[6], vip[7]}; }
        if (tq == 0) dk[ch] = total;
        if (c + 1 < SEG_CHUNKS) { const bf16* zr = z + (t0 + 64 + tq * 16) * DIN + hd * 128 + ch;
#pragma unroll
            for (int j = 0; j < 16; ++j) { rf[j] = zr[(size_t)j * DIN + ZF]; ri[j] = zr[(size_t)j * DIN + ZI]; if (FULL) rq[j] = zr[(size_t)j * DIN + ZQ]; } }
        u32x2 gwv[4];
        if (FULL) { const bf16* gr = z + (t0 + 16 * tb + fr) * DIN + ZG + hd * 128;
#pragma unroll
            for (int i = 0; i < 4; ++i) gwv[i] = *(const u32x2*)(gr + 16 * (vh * 4 + i) + 4 * fq); }
        BLOCK_SYNC();
        if (FULL) {
#pragma unroll
        for (int i = 0; i < 2; ++i) { const int sb = vh * 2 + i;
            f32x4 acc = (f32x4){0.f, 0.f, 0.f, 0.f};
            if (sb <= tb) acc = mma16<4>(Q + 16 * tb * QLD, QLD, Kt + 16 * sb * QLD, QLD, acc, fr, fq);
            const int t = 16 * tb + fr, s0 = 16 * sb + 4 * fq;
            u32x2 w; w.x = cvt_pk_bf16(s0 <= t ? acc[0] : 0.f, s0 + 1 <= t ? acc[1] : 0.f); w.y = cvt_pk_bf16(s0 + 2 <= t ? acc[2] : 0.f, s0 + 3 <= t ? acc[3] : 0.f);
            *(LAS u32x2*)(S + t * SLD + s0) = w; }
        BLOCK_SYNC();
        f32x4 o[4]; float ss = 0.f;
#pragma unroll
        for (int i = 0; i < 4; ++i) { const int vb = vh * 4 + i;
            f32x4 acc = (f32x4){0.f, 0.f, 0.f, 0.f};
            acc = mma16<2>(S + 16 * tb * SLD, SLD, VT + 16 * vb * SLD, SLD, acc, fr, fq);
            acc = mma16<4>(Q + 16 * tb * QLD, QLD, StT + 16 * vb * QLD, QLD, acc, fr, fq);
            o[i] = acc; ss += (acc[0] * acc[0] + acc[1] * acc[1]) + (acc[2] * acc[2] + acc[3] * acc[3]); }
        ss += __shfl_xor(ss, 16); ss += __shfl_xor(ss, 32);
        if (fq == 0) red[vh * 64 + 16 * tb + fr] = ss;
        BLOCK_SYNC();
        { const int t = 16 * tb + fr; const float rs = rsqrtf((red[t] + red[64 + t]) * (1.f / 128.f) + EPS);
          bf16* mr = mix + (t0 + t) * D + hd * 128;
#pragma unroll
          for (int i = 0; i < 4; ++i) { const int v0 = 16 * (vh * 4 + i) + 4 * fq;
              const u32x2 gw = gwv[i]; const f32x4 gg = ggv[i];
              const float g0 = __uint_as_float(gw.x << 16), g1 = __uint_as_float(gw.x & 0xffff0000u), g2 = __uint_as_float(gw.y << 16), g3 = __uint_as_float(gw.y & 0xffff0000u);
              u32x2 w; w.x = cvt_pk_bf16(o[i][0] * rs * gg[0] * silu_f(g0), o[i][1] * rs * gg[1] * silu_f(g1));
              w.y = cvt_pk_bf16(o[i][2] * rs * gg[2] * silu_f(g2), o[i][3] * rs * gg[3] * silu_f(g3));
              *(u32x2*)(mr + v0) = w; } }
        }
#pragma unroll
        for (int kb = 0; kb < 8; ++kb) { const f32x4 d4 = *(const LAS f32x4*)(dk + 16 * kb + 4 * fq);
            st[kb] = st[kb] * d4;
            st[kb] = mma16<2>(VT + 16 * wave * SLD, SLD, KsT + 16 * kb * SLD, SLD, st[kb], fr, fq);
            if (FULL) { u32x2 w; w.x = cvt_pk_bf16(st[kb][0], st[kb][1]); w.y = cvt_pk_bf16(st[kb][2], st[kb][3]);
                *(LAS u32x2*)(StT + (16 * wave + fr) * QLD + 16 * kb + 4 * fq) = w; } }
        BLOCK_SYNC();
    }
    if (!FULL) {
        float* So = HS + (size_t)item * 16384 + (16 * wave + fr) * 128 + 4 * fq;
#pragma unroll
        for (int kb = 0; kb < 8; ++kb) *(f32x4*)(So + 16 * kb) = st[kb];
        if (tq == 0) HD[item * 128 + ch] = dsum;
    }
}

__device__ __forceinline__ void lru_pass1(CArgs& a, LAS unsigned char* lds, int layer, int item, const bf16* z, float* LH, float* LP, float* LE) {
    const int tid = opaque_tid(), lane = tid & 63, wave = tid >> 6, fr = lane & 15, fq = lane >> 4;
    const int b = item >> 5, blk = (item >> 3) & 3, sgi = item & 7;
    LAS bf16* WaT = (LAS bf16*)(lds);
    LAS bf16* WxT = (LAS bf16*)(lds + 9216);
    LAS bf16* XC = (LAS bf16*)(lds + 18432);
    LAS float* XCf = (LAS float*)(lds + 27648);
    LAS float* Af = (LAS float*)(lds + 44032);
    LAS float* Uf = (LAS float*)(lds + 60416);
    LAS float* segP = (LAS float*)(lds + 76800);
    LAS float* segH = (LAS float*)(lds + 78848);
    LAS float* carry = (LAS float*)(lds + 80896);
    const int cbase = blk * 64;
    { const float* wa = a.in[I_WA] + ((size_t)layer * 4 + blk) * 4096; const float* wx = a.in[I_WX] + ((size_t)layer * 4 + blk) * 4096;
      for (int e = tid; e < 4096; e += NTHREADS) { const int i = e >> 6, j = e & 63; WaT[j * SLD + i] = f2bf(wa[e]); WxT[j * SLD + i] = f2bf(wx[e]); } }
    if (tid < 64) { carry[tid] = 0.f; carry[64 + tid] = 1.f; }
    const int ct = tid >> 3, c8 = (tid & 7) * 8;
    float cw[4][8], cb[8];
#pragma unroll
    for (int k = 0; k < 8; ++k) { cb[k] = a.in[I_CB][layer * 256 + cbase + c8 + k];
#pragma unroll
        for (int tap = 0; tap < 4; ++tap) cw[tap][k] = a.in[I_CW][(layer * 4 + tap) * 256 + cbase + c8 + k]; }
    const int tb = wave & 3, jh = wave >> 2;
    float gba[2][4], gbx[2][4], gsp[2][4];
#pragma unroll
    for (int i = 0; i < 2; ++i)
#pragma unroll
        for (int j = 0; j < 4; ++j) { const int col = 16 * (jh * 2 + i) + 4 * fq + j;
            gba[i][j] = a.in[I_BA][layer * 256 + cbase + col]; gbx[i][j] = a.in[I_BX][layer * 256 + cbase + col];
            const float lam = a.in[I_LAM][layer * 256 + cbase + col]; gsp[i][j] = log1pf(__expf(-lam)); }
    const int tl0 = sgi * 512;
    u32x4 xv[4];
#pragma unroll
    for (int tap = 0; tap < 4; ++tap) { const int tt = tl0 + ct + tap - 3; xv[tap] = (u32x4){0u, 0u, 0u, 0u};
        if (tt >= 0) xv[tap] = *(const u32x4*)(z + ((size_t)b * SEQ + tt) * DIN + ZX + cbase + c8); }
    BLOCK_SYNC();
    for (int c = 0; c < 8; ++c) {
        const size_t t0 = (size_t)b * SEQ + tl0 + c * 64;
        { float xc[8];
#pragma unroll
          for (int k = 0; k < 8; ++k) xc[k] = cb[k];
#pragma unroll
          for (int tap = 0; tap < 4; ++tap)
#pragma unroll
              for (int k = 0; k < 4; ++k) { xc[2 * k] += cw[tap][2 * k] * __uint_as_float(xv[tap][k] << 16); xc[2 * k + 1] += cw[tap][2 * k + 1] * __uint_as_float(xv[tap][k] & 0xffff0000u); }
          u32x4 w; w.x = cvt_pk_bf16(xc[0], xc[1]); w.y = cvt_pk_bf16(xc[2], xc[3]); w.z = cvt_pk_bf16(xc[4], xc[5]); w.w = cvt_pk_bf16(xc[6], xc[7]);
          *(LAS u32x4*)(XC + ct * SLD + c8) = w;
          *(LAS f32x4*)(XCf + ct * 64 + c8) = (f32x4){xc[0], xc[1], xc[2], xc[3]}; *(LAS f32x4*)(XCf + ct * 64 + c8 + 4) = (f32x4){xc[4], xc[5], xc[6], xc[7]}; }
        if (c + 1 < 8) {
#pragma unroll
            for (int tap = 0; tap < 4; ++tap) xv[tap] = *(const u32x4*)(z + (t0 + 64 + ct + tap - 3) * DIN + ZX + cbase + c8); }
        BLOCK_SYNC();
#pragma unroll
        for (int i = 0; i < 2; ++i) { const int jb = jh * 2 + i; const f32x4 zero = (f32x4){0.f, 0.f, 0.f, 0.f};
            const f32x4 ga = mma16<2>(XC + 16 * tb * SLD, SLD, WaT + 16 * jb * SLD, SLD, zero, fr, fq);
            const f32x4 gx = mma16<2>(XC + 16 * tb * SLD, SLD, WxT + 16 * jb * SLD, SLD, zero, fr, fq);
            const int t = 16 * tb + fr, col0 = 16 * jb + 4 * fq;
            const f32x4 xcv = *(const LAS f32x4*)(XCf + t * 64 + col0);
            f32x4 av, uv;
#pragma unroll
            for (int j = 0; j < 4; ++j) { const float r = fsigmoid(ga[j] + gba[i][j]), gi = fsigmoid(gx[j] + gbx[i][j]);
                const float la = -8.0f * r * gsp[i][j]; av[j] = __expf(la); uv[j] = __builtin_amdgcn_sqrtf(fmaxf(1.f - av[j] * av[j], 0.f)) * gi * xcv[j]; }
            *(LAS f32x4*)(Af + t * 64 + col0) = av; *(LAS f32x4*)(Uf + t * 64 + col0) = uv; }
        BLOCK_SYNC();
        { float av[8], uv[8]; float P = 1.f, H = 0.f;
#pragma unroll
          for (int k = 0; k < 8; ++k) { av[k] = Af[(wave * 8 + k) * 64 + lane]; uv[k] = Uf[(wave * 8 + k) * 64 + lane]; H = av[k] * H + uv[k]; P *= av[k]; }
          segP[wave * 64 + lane] = P; segH[wave * 64 + lane] = H;
          BLOCK_SYNC();
          float h = carry[lane], p = carry[64 + lane];
          for (int q = 0; q < wave; ++q) { const float sp = segP[q * 64 + lane]; h = sp * h + segH[q * 64 + lane]; p *= sp; }
          float* lh = LH + (t0 + wave * 8) * 256 + cbase + lane; float* lp = LP + (t0 + wave * 8) * 256 + cbase + lane;
#pragma unroll
          for (int k = 0; k < 8; ++k) { h = av[k] * h + uv[k]; p *= av[k]; lh[k * 256] = h; lp[k * 256] = p; }
          BLOCK_SYNC();
          if (wave == 7) { carry[lane] = h; carry[64 + lane] = p; } }
    }
    BLOCK_SYNC();
    if (tid < 64) { LE[item * 128 + tid] = carry[64 + tid]; LE[item * 128 + 64 + tid] = carry[tid]; }
    BLOCK_SYNC();
}
__device__ __forceinline__ void lru_pass2(CArgs& a, int layer, int bx, const bf16* z, bf16* mix, const float* LH, const float* LP, const float* LE) {
    const int tid = opaque_tid();
    const int b = bx >> 5, sgi = (bx >> 2) & 7;
    const int tl = tid >> 3, c8 = (tid & 7) * 8;
#pragma unroll 1
    for (int blk = 0; blk < 4; ++blk) {
        float cin[8];
#pragma unroll
        for (int k = 0; k < 8; ++k) cin[k] = 0.f;
        for (int j = 0; j < sgi; ++j) { const float* le = LE + (size_t)((b * 4 + blk) * 8 + j) * 128 + c8;
            const f32x4 p0 = *(const f32x4*)le, p1 = *(const f32x4*)(le + 4), h0 = *(const f32x4*)(le + 64), h1 = *(const f32x4*)(le + 68);
#pragma unroll
            for (int k = 0; k < 4; ++k) { cin[k] = p0[k] * cin[k] + h0[k]; cin[4 + k] = p1[k] * cin[4 + k] + h1[k]; } }
        const float* ng = a.in[I_LN] + layer * 256 + blk * 64 + c8;
        const f32x4 g0 = *(const f32x4*)ng, g1 = *(const f32x4*)(ng + 4);
#pragma unroll
        for (int hh = 0; hh < 2; ++hh) { const size_t t = (size_t)bx * 128 + hh * 64 + tl;
            const float* lh = LH + t * 256 + blk * 64 + c8; const float* lp = LP + t * 256 + blk * 64 + c8;
            const f32x4 h0 = *(const f32x4*)lh, h1 = *(const f32x4*)(lh + 4), p0 = *(const f32x4*)lp, p1 = *(const f32x4*)(lp + 4);
            const u32x4 gv = *(const u32x4*)(z + t * DIN + ZGATE + blk * 64 + c8);
            float y[8]; float ss = 0.f;
#pragma unroll
            for (int k = 0; k < 4; ++k) { const float ge = __uint_as_float(gv[k] << 16), go = __uint_as_float(gv[k] & 0xffff0000u);
                const float he = (k < 2 ? h0[2 * k] : h1[2 * k - 4]) + (k < 2 ? p0[2 * k] : p1[2 * k - 4]) * cin[2 * k];
                const float ho = (k < 2 ? h0[2 * k + 1] : h1[2 * k - 3]) + (k < 2 ? p0[2 * k + 1] : p1[2 * k - 3]) * cin[2 * k + 1];
                y[2 * k] = he * gelu_t(ge); y[2 * k + 1] = ho * gelu_t(go); ss += y[2 * k] * y[2 * k] + y[2 * k + 1] * y[2 * k + 1]; }
            ss += __shfl_xor(ss, 1); ss += __shfl_xor(ss, 2); ss += __shfl_xor(ss, 4);
            const float rs = rsqrtf(ss * (1.f / 64.f) + EPS);
            u32x4 w; w.x = cvt_pk_bf16(y[0] * rs * g0[0], y[1] * rs * g0[1]); w.y = cvt_pk_bf16(y[2] * rs * g0[2], y[3] * rs * g0[3]);
            w.z = cvt_pk_bf16(y[4] * rs * g1[0], y[5] * rs * g1[1]); w.w = cvt_pk_bf16(y[6] * rs * g1[2], y[7] * rs * g1[3]);
            *(u32x4*)(mix + t * D + 512 + blk * 64 + c8) = w; }
    }
}

__device__ __forceinline__ void sgu_items(CArgs& a, LAS unsigned char* lds, int layer, int first, int stride, const bf16* z, bf16* mix) {
    const int tid = opaque_tid(), lane = tid & 63, wave = tid >> 6, fr = lane & 15, fq = lane >> 4;
    LAS bf16* Wm = (LAS bf16*)(lds);
    LAS bf16* VnT = (LAS bf16*)(lds + 34816);
    int cur_grp = -1;
    for (int it = first; it < BATCH * 32 * 4; it += stride) {
        const int grp = it & 3, bn = it >> 2; const size_t t0 = (size_t)bn * 128;
        if (grp != cur_grp) { cur_grp = grp;
            const float* ws = a.in[I_SW] + ((size_t)layer * 4 + grp) * 16384;
            for (int e = tid; e < 4096; e += NTHREADS) { const int t = e >> 5, s0 = (e & 31) * 4; const f32x4 wv = *(const f32x4*)(ws + t * 128 + s0);
                u32x2 w; w.x = cvt_pk_bf16(s0 <= t ? wv[0] : 0.f, s0 + 1 <= t ? wv[1] : 0.f); w.y = cvt_pk_bf16(s0 + 2 <= t ? wv[2] : 0.f, s0 + 3 <= t ? wv[3] : 0.f);
                *(LAS u32x2*)(Wm + t * QLD + s0) = w; } }
        { const int s = tid >> 2, cq = tid & 3; const bf16* vr = z + (t0 + s) * DIN + ZV + grp * 64 + cq * 16;
          const u32x4 r0 = *(const u32x4*)vr, r1 = *(const u32x4*)(vr + 8);
          float v[16]; float sum = 0.f;
#pragma unroll
          for (int k = 0; k < 4; ++k) { v[2 * k] = gelu_t(__uint_as_float(r0[k] << 16)); v[2 * k + 1] = gelu_t(__uint_as_float(r0[k] & 0xffff0000u));
              v[8 + 2 * k] = gelu_t(__uint_as_float(r1[k] << 16)); v[8 + 2 * k + 1] = gelu_t(__uint_as_float(r1[k] & 0xffff0000u)); }
#pragma unroll
          for (int k = 0; k < 16; ++k) sum += v[k];
          sum += __shfl_xor(sum, 1); sum += __shfl_xor(sum, 2);
          const float mu = sum * (1.f / 64.f); float sq = 0.f;
#pragma unroll
          for (int k = 0; k < 16; ++k) { v[k] -= mu; sq += v[k] * v[k]; }
          sq += __shfl_xor(sq, 1); sq += __shfl_xor(sq, 2);
          const float rs = rsqrtf(sq * (1.f / 64.f) + EPS);
#pragma unroll
          for (int k = 0; k < 16; ++k) VnT[(cq * 16 + k) * QLD + s] = f2bf(v[k] * rs); }
        BLOCK_SYNC();
        { const int t = 16 * wave + fr; f32x4 y[4]; float ss = 0.f;
          const float bias = a.in[I_SB][((size_t)layer * 4 + grp) * 128 + t];
          const bf16* ur = z + (t0 + t) * DIN + ZU + grp * 64;
#pragma unroll
          for (int cb = 0; cb < 4; ++cb) { f32x4 acc = (f32x4){0.f, 0.f, 0.f, 0.f};
              acc = mma16<4>(Wm + 16 * wave * QLD, QLD, VnT + 16 * cb * QLD, QLD, acc, fr, fq);
              const u32x2 uw = *(const u32x2*)(ur + 16 * cb + 4 * fq);
              const float u0 = __uint_as_float(uw.x << 16), u1 = __uint_as_float(uw.x & 0xffff0000u), u2 = __uint_as_float(uw.y << 16), u3 = __uint_as_float(uw.y & 0xffff0000u);
              y[cb] = (f32x4){gelu_t(u0) * (acc[0] + bias), gelu_t(u1) * (acc[1] + bias), gelu_t(u2) * (acc[2] + bias), gelu_t(u3) * (acc[3] + bias)};
              ss += (y[cb][0] * y[cb][0] + y[cb][1] * y[cb][1]) + (y[cb][2] * y[cb][2] + y[cb][3] * y[cb][3]); }
          ss += __shfl_xor(ss, 16); ss += __shfl_xor(ss, 32);
          const float rs = SG_SCALE * rsqrtf(ss * (1.f / 64.f) + EPS);
          const float* ng = a.in[I_SN] + layer * 256 + grp * 64; bf16* mr = mix + (t0 + t) * D + 768 + grp * 64;
#pragma unroll
          for (int cb = 0; cb < 4; ++cb) { const f32x4 gg = *(const f32x4*)(ng + 16 * cb + 4 * fq);
              u32x2 w; w.x = cvt_pk_bf16(y[cb][0] * rs * gg[0], y[cb][1] * rs * gg[1]); w.y = cvt_pk_bf16(y[cb][2] * rs * gg[2], y[cb][3] * rs * gg[3]);
              *(u32x2*)(mr + 16 * cb + 4 * fq) = w; } }
        BLOCK_SYNC();
    }
}

#define XB_TMO      128
#define XB_XCNT(j)  (256  + 64 * (j))
#define XB_XSUB(j)  (1280 + 64 * (j))
#define XB_XGEN(j)  (2304 + 64 * (j))
#define XB_TOP      3328
#define XB_TOPGEN   3392
#define XCD_BAR_WORDS 3456
#define XB_SPIN_CAP (1u << 18)

__device__ __forceinline__ unsigned xb_ld(unsigned* p)              { return __hip_atomic_load(p, __ATOMIC_RELAXED, __HIP_MEMORY_SCOPE_AGENT); }
__device__ __forceinline__ unsigned xb_add(unsigned* p, unsigned v) { return __hip_atomic_fetch_add(p, v, __ATOMIC_RELAXED, __HIP_MEMORY_SCOPE_AGENT); }
__device__ __forceinline__ unsigned xb_xcc_id() { return (unsigned)__builtin_amdgcn_s_getreg((3 << 11) | 20) & 0xFu; }
#define XB_SPIN(cond, bar) do { unsigned _sp = 0; while (cond) { __builtin_amdgcn_s_sleep(1); \
    if ((++_sp & 255u) == 0u) { if (xb_ld(&(bar)[XB_TMO])) break; if (_sp > XB_SPIN_CAP) { atomicAdd(&(bar)[XB_TMO], 1u); break; } } } } while (0)

struct XcdBarrier {
    unsigned* bar; unsigned x;
    volatile LAS unsigned* st;
};

__device__ __forceinline__ XcdBarrier xcd_barrier_post(unsigned* bar, volatile LAS unsigned* st) {
    XcdBarrier b; b.bar = bar; b.x = xb_xcc_id(); b.st = st;
    if (threadIdx.x == 0) (void)xb_add(&bar[XB_XCNT(b.x)], 1u);
    return b;
}
__device__ __forceinline__ void xcd_barrier_complete(unsigned* bar, unsigned x, unsigned& nloc, unsigned& nx) {
    const unsigned G = gridDim.x * gridDim.y * gridDim.z;
    unsigned sum, cnt, mine, sp = 0u;
    for (;;) {
        sum = 0u; cnt = 0u; mine = 0u;
#pragma unroll
        for (unsigned j = 0; j < 16; ++j) { const unsigned c = xb_ld(&bar[XB_XCNT(j)]); sum += c; cnt += (c > 0u) ? 1u : 0u; mine = (j == x) ? c : mine; }
        if (sum == G) break;
        __builtin_amdgcn_s_sleep(1);
        if ((++sp & 255u) == 0u) { if (xb_ld(&bar[XB_TMO])) break; if (sp > XB_SPIN_CAP) { atomicAdd(&bar[XB_TMO], 1u); break; } }
    }
    nloc = mine > 0u ? mine : 1u; nx = cnt > 0u ? cnt : 1u;
}

__device__ __forceinline__ void xcd_barrier(const XcdBarrier& b) {
    asm volatile("s_waitcnt vmcnt(0)" ::: "memory");
    __syncthreads();
    if (threadIdx.x == 0) {
        unsigned* bar = b.bar;
        __builtin_amdgcn_s_waitcnt(0);
        unsigned nloc = b.st[0], nx = b.st[1];
        if (nloc == 0u) { xcd_barrier_complete(bar, b.x, nloc, nx); b.st[0] = nloc; b.st[1] = nx; }
        const unsigned old = xb_add(&bar[XB_XSUB(b.x)], 1u);
        const unsigned gen = old / nloc;
        if (old + 1u == (gen + 1u) * nloc) {
            __builtin_amdgcn_fence(__ATOMIC_RELEASE, "agent");
            asm volatile("s_waitcnt vmcnt(0)" ::: "memory");
            const unsigned og = xb_add(&bar[XB_TOP], 1u);
            const unsigned tg = og / nx;
            if (og + 1u == (tg + 1u) * nx) xb_add(&bar[XB_TOPGEN], 1u);
            else XB_SPIN(xb_ld(&bar[XB_TOPGEN]) == tg, bar);
            __builtin_amdgcn_fence(__ATOMIC_ACQUIRE, "agent");
            xb_add(&bar[XB_XGEN(b.x)], 1u);
            asm volatile("s_waitcnt vmcnt(0)" ::: "memory");
        } else {
            XB_SPIN(xb_ld(&bar[XB_XGEN(b.x)]) == gen, bar);
            __builtin_amdgcn_fence(__ATOMIC_ACQUIRE, "agent");
            asm volatile("s_waitcnt vmcnt(0)" ::: "memory");
        }
    }
    __syncthreads();
}

template <class Epi, int ID>
__device__ __forceinline__ void run_gemm(LAS unsigned char* lds, const bf16* A, const bf16* Bt, int N, int K, int G, int bx, const Epi& E) {
#ifndef NO_GEMM
    if (ID & GEMM_MASK) return;
    pg8::Gemm g{A, Bt, T, N, K}; pg8::StaticOrder S; S.init(T, N, G, bx);
    pg8::gemm_phase<Epi, pg8::StaticOrder, true, true>(lds, g, S, E);
#endif
}
__device__ __forceinline__ CArgs* args_ptr() { CArgs* p = (CArgs*)__builtin_amdgcn_kernarg_segment_ptr(); asm volatile("" : "+s"(p)); return p; }
__global__ void __launch_bounds__(NTHREADS, 2) fwd_kernel(Args a_unused) {
    extern __shared__ __attribute__((aligned(16))) unsigned char lds_raw[];
    LAS unsigned char* lds = (LAS unsigned char*)lds_raw;
    cg::grid_group grid = cg::this_grid();
    volatile LAS unsigned* MISC = (volatile LAS unsigned*)(lds + 131072 + 320);
    if (threadIdx.x < 32) MISC[threadIdx.x] = 0u;
    __syncthreads();
    (void)xcd_barrier_post((unsigned*)args_ptr()->ws, MISC + 8);
#define GRID_BAR() do { XcdBarrier b_; b_.bar = (unsigned*)args_ptr()->ws; b_.x = xb_xcc_id(); b_.st = (volatile LAS unsigned*)(lds + 131072 + 320) + 8; xcd_barrier(b_); } while (0)
    const int tid = threadIdx.x, lane = tid & 63, wave = __builtin_amdgcn_readfirstlane(tid >> 6);
    const int G = gridDim.x, bx = blockIdx.x;
    const int gw = bx * NWAVES + wave, NGW = G * NWAVES;
    { CArgs& a = *args_ptr();
      convert_weights(a, lds, bx, G);
      norm_rows<false, false>(a.in[I_X], nullptr, 0.f, nullptr, a.in[I_F1N], (bf16*)(a.ws + WS_XN), nullptr, nullptr, gw, NGW, lane); }
    grid.sync();
    GRID_BAR();
    constexpr int NPH = 11;
#pragma nounroll
    for (int ph = 0; ph < DEPTH * NPH; ++ph) {
        const int layer = ph / NPH, p = ph - layer * NPH;
        CArgs& a = *args_ptr();
        bf16* h = (bf16*)a.out; bf16* xn = (bf16*)(a.ws + WS_XN); bf16* mix = xn; bf16* zb = (bf16*)(a.ws + WS_Z); bf16* act = zb;
        const bf16* wl = (const bf16*)(a.ws + WS_W + (size_t)layer * W_LAYER);
        if (p == 0 || p == 8) {
            run_gemm<pg8::EpiSwiGLU, 1>(lds, xn, wl + (p == 0 ? OFF_GU1 : OFF_GU2) / 2, 2 * FF, D, G, bx, pg8::EpiSwiGLU{act, FF});
        } else if (p == 1 || p == 9 || p == 3 || p == 6) {
            const bool dn = (p == 1 || p == 9);
            const bf16* A = dn ? act : xn; const size_t wo = (p == 1) ? OFF_D1 : (p == 9) ? OFF_D2 : (p == 3) ? OFF_IN : OFF_OUT;
            const int N = (p == 3) ? DIN : D, K = dn ? FF : D; bf16* O = dn ? xn : zb;
            run_gemm<pg8::EpiStoreBf16, 4>(lds, A, wl + wo / 2, N, K, G, bx, pg8::EpiStoreBf16{O, N});
        } else if (p == 4) {
            float* HS = (float*)(a.ws + WS_HS); float* HD = (float*)(a.ws + WS_HD);
            for (int it = bx; it < 256; it += G) if ((it & 7) != 7) hgrn_seg<false>(a, lds, layer, it, zb, mix, HS, HD);
            for (int it = bx; it < 256; it += G) lru_pass1(a, lds, layer, it, zb, (float*)(a.ws + WS_LH), (float*)(a.ws + WS_LP), (float*)(a.ws + WS_LE));
            sgu_items(a, lds, layer, bx, G, zb, mix);
        } else if (p == 5) {
            float* HS = (float*)(a.ws + WS_HS); float* HD = (float*)(a.ws + WS_HD);
            for (int it = bx; it < 256; it += G) hgrn_seg<true>(a, lds, layer, it, zb, mix, HS, HD);
            for (int it = bx; it < 256; it += G) lru_pass2(a, layer, it, zb, mix, (const float*)(a.ws + WS_LH), (const float*)(a.ws + WS_LP), (const float*)(a.ws + WS_LE));
        } else {
            const bf16* y = (p == 7) ? zb : xn; const float ys = (p == 7) ? 1.0f : 0.5f; const int lane = opaque_tid() & 63;
            if (p == 10 && layer == DEPTH - 1) norm_rows<true, true>(h, y, ys, nullptr, a.in[I_FN], nullptr, a.out, (float*)(a.ws + WS_Z), gw, NGW, lane);
            else { const float* gain = (p == 2) ? a.in[I_MIXN] + layer * D : (p == 7) ? a.in[I_F2N] + layer * D : a.in[I_F1N] + (layer + 1) * D;
                if (ph == 2) norm_rows<false, false>(a.in[I_X], y, ys, h, gain, xn, nullptr, nullptr, gw, NGW, lane);
                else norm_rows<true, false>(h, y, ys, h, gain, xn, nullptr, nullptr, gw, NGW, lane); }
        }
        GRID_BAR();
    }
    { CArgs& a = *args_ptr(); copy_rows((const float*)(a.ws + WS_Z), a.out, gw, NGW, opaque_tid() & 63); }
}

extern "C" void kernel_launch(void* const* d_in, const int* in_sizes, int n_in, void* d_out, int out_size, void* d_ws, size_t ws_size, hipStream_t stream) {
    static int grid = 0;
    if (grid == 0) {
        if (n_in != 26 || in_sizes[0] != T * D || out_size != T * D || ws_size < WS_END) {
            fprintf(stderr, "kernel_launch: unexpected shapes: n_in %d in0 %d out %d ws %zu (need %zu)\n", n_in, n_in > 0 ? in_sizes[0] : -1, out_size, ws_size, (size_t)WS_END); grid = -1; return; }
        int dev = 0, cus = 0, per_cu = 0;
        (void)hipGetDevice(&dev); (void)hipDeviceGetAttribute(&cus, hipDeviceAttributeMultiprocessorCount, dev);
        if (hipFuncSetAttribute((const void*)fwd_kernel, hipFuncAttributeMaxDynamicSharedMemorySize, LDS_BYTES) != hipSuccess) { fprintf(stderr, "kernel_launch: hipFuncSetAttribute failed\n"); grid = -1; return; }
        if (hipOccupancyMaxActiveBlocksPerMultiprocessor(&per_cu, (const void*)fwd_kernel, NTHREADS, LDS_BYTES) != hipSuccess || per_cu < 1) { fprintf(stderr, "kernel_launch: occupancy query gave %d\n", per_cu); per_cu = 1; }
        (void)hipGetLastError();
        grid = cus * per_cu;
        if (grid < 128) { fprintf(stderr, "kernel_launch: grid %d too small\n", grid); grid = -1; return; }
    }
    if (grid < 0) return;
    if (hipMemsetAsync(d_ws, 0, 65536, stream) != hipSuccess) { fprintf(stderr, "kernel_launch: memset failed\n"); return; }
    Args a{};
    for (int i = 0; i < 26; ++i) a.in[i] = (const float*)d_in[i];
    a.out = (float*)d_out; a.ws = (unsigned char*)d_ws;
    void* args[] = {&a};
    hipError_t e = hipLaunchCooperativeKernel((const void*)fwd_kernel, dim3(grid), dim3(NTHREADS), args, LDS_BYTES, stream);
    if (e != hipSuccess) fprintf(stderr, "kernel_launch: cooperative launch failed: %s (grid %d)\n", hipGetErrorString(e), grid);
}
```

```cpp
#include <hip/hip_runtime.h>
#include <hip/hip_cooperative_groups.h>
#include <cstdio>
#include <cstdint>
namespace cg = cooperative_groups;
namespace pg8 {
#define PG8_LAS __attribute__((address_space(3)))
typedef unsigned short bf16_t;
typedef short bf16x8 __attribute__((ext_vector_type(8)));
typedef float f32x4 __attribute__((ext_vector_type(4)));
typedef unsigned u32x4 __attribute__((ext_vector_type(4)));
constexpr int BM = 256, BK = 64, HALF = 128, HTB = HALF * BK * 2  , STAGE_BYTES = 8 * HTB, NXCD = 8, WGM = 8;

__host__ __device__ __forceinline__ int lds_byte(int r, int c) { const int st = (r >> 4) * 2 + (c >> 5), rr = r & 15, cc = c & 31, ob = rr * 64 + cc * 2; return st * 1024 + (ob ^ (((ob >> 9) & 1) << 5)); }
__host__ __device__ __forceinline__ void stage_rc(int b, int& R, int& C) { const int st = b / 1024, sb = b % 1024, swz = sb ^ (((sb >> 9) & 1) << 5); R = (st >> 1) * 16 + swz / 64; C = (st & 1) * 32 + (swz % 64) / 2; }
__host__ __device__ __forceinline__ int perm32(int rho) { const int n = rho >> 4, i = rho & 15; return 8 * (i >> 2) + 4 * n + (i & 3); }

struct Unit { int pm, pn; };
struct Gemm { const bf16_t* A; const bf16_t* Bt; int M, N, K; };

struct StaticOrder {
    int nM, nN, nwg, G, c;
    __host__ __device__ void init(int M, int N, int G_, int c_) { nM = M / BM; nN = N / BM; nwg = nM * nN; G = G_; c = c_; }
    __host__ __device__ bool next(int i, Unit& u) const {
        const long L = (long)i * G + c; if (L >= nwg) return false;
        int wgid = (int)L; { const int q = nwg / NXCD, r = nwg % NXCD, xcd = wgid % NXCD, off = wgid / NXCD; wgid = (xcd < r ? xcd * (q + 1) : r * (q + 1) + (xcd - r) * q) + off; }
        const int nig = WGM * nN, gid = wgid / nig, fm = gid * WGM, gsz = (nM - fm) < WGM ? (nM - fm) : WGM;
        u.pm = fm + ((wgid % nig) % gsz); u.pn = (wgid % nig) / gsz; return true;
    }
    __device__ __forceinline__ void a_ready(const Unit&) const {}
    __device__ __forceinline__ void done(const Unit&) const {}
};

typedef __bf16 bf16x2_t __attribute__((ext_vector_type(2)));
typedef float f32x2_t __attribute__((ext_vector_type(2)));
__device__ __forceinline__ unsigned cvt_pk_bf16(float lo, float hi) { f32x2_t v = {lo, hi}; bf16x2_t b = __builtin_convertvector(v, bf16x2_t); return __builtin_bit_cast(unsigned, b); }
__device__ __forceinline__ float fsigmoid(float x) { return __builtin_amdgcn_rcpf(1.0f + __expf(-x)); }
struct EpiSwiGLU {
    static constexpr bool PERM = true, AFTER_DRAIN = false;
    bf16_t* O; int ldc;
    __device__ __forceinline__ void operator()(const f32x4 (&acc)[2][2][4][2], const Unit& u, int wr, int wc, int fr, int fq) const {
        const int row0 = u.pm * BM + wr * 64 + fr, col0 = u.pn * HALF + wc * 32 + 8 * fq;
#pragma unroll
        for (int ai = 0; ai < 2; ++ai)
#pragma unroll
            for (int m = 0; m < 4; ++m) { bf16_t* rowp = O + (size_t)(row0 + ai * HALF + m * 16) * ldc + col0;
                float v[8];
#pragma unroll
                for (int n = 0; n < 2; ++n)
#pragma unroll
                    for (int j = 0; j < 4; ++j) { const float g = acc[ai][0][m][n][j], up = acc[ai][1][m][n][j]; v[n * 4 + j] = g * fsigmoid(g) * up; }
                u32x4 w; w.x = cvt_pk_bf16(v[0], v[1]); w.y = cvt_pk_bf16(v[2], v[3]); w.z = cvt_pk_bf16(v[4], v[5]); w.w = cvt_pk_bf16(v[6], v[7]);
                *(u32x4*)rowp = w; }
    }
};
struct EpiStoreBf16 {
    static constexpr bool PERM = true, AFTER_DRAIN = false;
    bf16_t* O; int ldc;
    __device__ __forceinline__ void operator()(const f32x4 (&acc)[2][2][4][2], const Unit& u, int wr, int wc, int fr, int fq) const {
        const int row0 = u.pm * BM + wr * 64 + fr, col0 = u.pn * BM + wc * 32 + 8 * fq;
#pragma unroll
        for (int ai = 0; ai < 2; ++ai)
#pragma unroll
            for (int m = 0; m < 4; ++m) { bf16_t* rowp = O + (size_t)(row0 + ai * HALF + m * 16) * ldc + col0;
#pragma unroll
                for (int bj = 0; bj < 2; ++bj) { const f32x4 v0 = acc[ai][bj][m][0], v1 = acc[ai][bj][m][1];
                    u32x4 w; w.x = cvt_pk_bf16(v0[0], v0[1]); w.y = cvt_pk_bf16(v0[2], v0[3]); w.z = cvt_pk_bf16(v1[0], v1[1]); w.w = cvt_pk_bf16(v1[2], v1[3]);
                    *(u32x4*)(rowp + bj * HALF) = w; } }
    }
};
struct EpiResidual {
    static constexpr bool PERM = false, AFTER_DRAIN = false;
    float* H; int ldc; float scale;
    __device__ __forceinline__ void operator()(const f32x4 (&acc)[2][2][4][2], const Unit& u, int wr, int wc, int fr, int fq) const {
        const int col0 = u.pn * BM + wc * 32 + 4 * fq;
#pragma unroll
        for (int ai = 0; ai < 2; ++ai)
#pragma unroll
            for (int m = 0; m < 4; ++m) { float* rowp = H + (size_t)(u.pm * BM + ai * HALF + wr * 64 + m * 16 + fr) * ldc + col0;
#pragma unroll
                for (int bj = 0; bj < 2; ++bj)
#pragma unroll
                    for (int n = 0; n < 2; ++n) { f32x4* p = (f32x4*)(rowp + bj * HALF + n * 16); const f32x4 o = *p + acc[ai][bj][m][n] * scale; *p = o; }
                asm volatile("" ::: "memory"); }
    }
};
template <class Epi, class Sched, bool ALIGN_EPI = false, bool SP2 = false>
__device__ __forceinline__ void gemm_phase(PG8_LAS unsigned char* lds, const Gemm g, const Sched& S, const Epi& E) {
    const int tid = threadIdx.x, wid = __builtin_amdgcn_readfirstlane(tid >> 6), lane = tid & 63, wr = wid >> 2, wc = wid & 3, fr = lane & 15, fq = lane >> 4;
    const int K = g.K, nt = K / BK;
    unsigned voffA[2], voffB[2];
#pragma unroll
    for (int i = 0; i < 2; ++i) { int R, C; stage_rc(tid * 16 + i * 8192, R, C); const int Rb = Epi::PERM ? ((R & ~31) + perm32(R & 31)) : R;
        voffA[i] = (unsigned)(R * K + C) * 2u; voffB[i] = (unsigned)(Rb * K + C) * 2u; }
    const size_t kstep = (size_t)(BK * 2);
    const size_t hstep = (size_t)HALF * K * 2;
    const size_t tstep = 2 * hstep;
    const unsigned ldsw = (unsigned)wid * 1024u;
    const int aoff = lds_byte(wr * 64 + fr, fq * 8), boff = lds_byte(wc * 32 + fr, fq * 8);
#define PG8_SA(b, h) (((b) * 2 + (h)) * HTB)
#define PG8_SB(b, h) ((4 + (b) * 2 + (h)) * HTB)
#define PG8_STAGE(bufoff, gbase, voff) do { _Pragma("unroll") for (int _i = 0; _i < 2; ++_i) \
        __builtin_amdgcn_global_load_lds((const unsigned*)((const char*)(gbase) + (voff)[_i]), (PG8_LAS unsigned*)(lds + (bufoff) + ldsw + _i * 8192), 16, 0, 0); } while (0)
#define PG8_LDA(dst, b, h) do { _Pragma("unroll") for (int m = 0; m < 4; ++m) _Pragma("unroll") for (int k = 0; k < 2; ++k) dst[m][k] = *(const PG8_LAS bf16x8*)(lds + PG8_SA(b, h) + aoff + m * 2048 + k * 1024); } while (0)
#define PG8_LDB(dst, b, h) do { _Pragma("unroll") for (int n = 0; n < 2; ++n) _Pragma("unroll") for (int k = 0; k < 2; ++k) dst[n][k] = *(const PG8_LAS bf16x8*)(lds + PG8_SB(b, h) + boff + n * 2048 + k * 1024); } while (0)
#define PG8_MMA(ai, bj, At, Bt) do { __builtin_amdgcn_s_setprio(1); _Pragma("unroll") for (int m = 0; m < 4; ++m) _Pragma("unroll") for (int n = 0; n < 2; ++n) _Pragma("unroll") for (int k = 0; k < 2; ++k) \
        acc[ai][bj][m][n] = __builtin_amdgcn_mfma_f32_16x16x32_bf16(Bt[n][k], At[m][k], acc[ai][bj][m][n], 0, 0, 0); __builtin_amdgcn_s_setprio(0); } while (0)
#define PG8_WAIT_V(n) asm volatile("s_waitcnt vmcnt(" #n ")" ::: "memory")
#define PG8_WAIT_L(n) asm volatile("s_waitcnt lgkmcnt(" #n ")" ::: "memory")
#define PG8_BAR __builtin_amdgcn_s_barrier()
#define PG8_SCHED __builtin_amdgcn_sched_barrier(0)
    Unit cur, nxt; int ui = 0;
    if (!S.next(0, cur)) return;
    f32x4 acc[2][2][4][2];
#pragma unroll
    for (int a = 0; a < 2; ++a)
#pragma unroll
        for (int b = 0; b < 2; ++b)
#pragma unroll
            for (int m = 0; m < 4; ++m)
#pragma unroll
                for (int n = 0; n < 2; ++n) acc[a][b][m][n] = (f32x4){0.f, 0.f, 0.f, 0.f};
    bf16x8 At[4][2], B0[2][2], B1[2][2];
    const char* cA = (const char*)g.A + (size_t)cur.pm * tstep; const char* cB = (const char*)g.Bt + (size_t)cur.pn * tstep;
    S.a_ready(cur);
    if constexpr (SP2) {
        PG8_STAGE(PG8_SB(0, 0), cB, voffB); PG8_STAGE(PG8_SB(0, 1), cB + hstep, voffB); PG8_STAGE(PG8_SA(0, 0), cA, voffA); PG8_STAGE(PG8_SA(0, 1), cA + hstep, voffA);
        if (wr == 1) PG8_BAR;
        PG8_WAIT_V(2); PG8_BAR;
        PG8_STAGE(PG8_SB(1, 0), cB + kstep, voffB); PG8_STAGE(PG8_SA(1, 0), cA + kstep, voffA); PG8_STAGE(PG8_SB(1, 1), cB + hstep + kstep, voffB);
        PG8_WAIT_V(6); PG8_BAR;
    } else {
        PG8_STAGE(PG8_SB(0, 0), cB, voffB); PG8_STAGE(PG8_SA(0, 0), cA, voffA); PG8_STAGE(PG8_SB(0, 1), cB + hstep, voffB); PG8_STAGE(PG8_SA(0, 1), cA + hstep, voffA);
        if (wr == 1) PG8_BAR;
        PG8_WAIT_V(4); PG8_BAR;
        PG8_STAGE(PG8_SB(1, 0), cB + kstep, voffB); PG8_STAGE(PG8_SA(1, 0), cA + kstep, voffA); PG8_STAGE(PG8_SB(1, 1), cB + hstep + kstep, voffB);
        PG8_WAIT_V(6); PG8_BAR;
    }
    for (;;) {
        const bool has_next = S.next(ui + 1, nxt);
        const char* nA = has_next ? (const char*)g.A + (size_t)nxt.pm * tstep : cA; const char* nB = has_next ? (const char*)g.Bt + (size_t)nxt.pn * tstep : cB;
        for (int t = 0; t < nt; t += 2) {
            const bool last = (t == nt - 2);
            const char* a1 = cA + (size_t)(t + 1) * kstep;
            const char* a2 = last ? nA : cA + (size_t)(t + 2) * kstep; const char* b2 = last ? nB : cB + (size_t)(t + 2) * kstep;
            const char* a3 = a2 + kstep; const char* b3 = b2 + kstep;
            if (last && has_next) S.a_ready(nxt);
            if constexpr (SP2) {
            PG8_LDB(B0, 0, 0); PG8_LDB(B1, 0, 1); PG8_SCHED; PG8_LDA(At, 0, 0); PG8_STAGE(PG8_SA(1, 1), a1 + hstep, voffA);
            PG8_WAIT_V(8); PG8_WAIT_L(0); PG8_BAR; PG8_MMA(0, 0, At, B0); PG8_MMA(0, 1, At, B1); PG8_BAR; PG8_SCHED;
            PG8_LDA(At, 0, 1); PG8_STAGE(PG8_SB(0, 0), b2, voffB); PG8_STAGE(PG8_SB(0, 1), b2 + hstep, voffB); PG8_STAGE(PG8_SA(0, 0), a2, voffA);
            PG8_WAIT_V(8); PG8_WAIT_L(0); PG8_BAR; PG8_MMA(1, 0, At, B0); PG8_MMA(1, 1, At, B1); PG8_BAR; PG8_SCHED;
            PG8_LDB(B0, 1, 0); PG8_LDB(B1, 1, 1); PG8_SCHED; PG8_LDA(At, 1, 0); PG8_STAGE(PG8_SA(0, 1), a2 + hstep, voffA);
            PG8_WAIT_V(8); PG8_WAIT_L(0); PG8_BAR; PG8_MMA(0, 0, At, B0); PG8_MMA(0, 1, At, B1); PG8_BAR; PG8_SCHED;
            PG8_LDA(At, 1, 1); PG8_STAGE(PG8_SB(1, 0), b3, voffB); PG8_STAGE(PG8_SB(1, 1), b3 + hstep, voffB); PG8_STAGE(PG8_SA(1, 0), a3, voffA);
            PG8_WAIT_V(8); PG8_WAIT_L(0); PG8_BAR; PG8_MMA(1, 0, At, B0); PG8_MMA(1, 1, At, B1); PG8_BAR; PG8_SCHED;
            } else {
            PG8_LDB(B0, 0, 0); PG8_SCHED; PG8_LDA(At, 0, 0); PG8_STAGE(PG8_SA(1, 1), a1 + hstep, voffA);
            PG8_WAIT_L(8); PG8_BAR; PG8_WAIT_L(0); PG8_MMA(0, 0, At, B0); PG8_BAR; PG8_SCHED;
            PG8_LDB(B1, 0, 1); PG8_STAGE(PG8_SB(0, 0), b2, voffB);
            PG8_BAR; PG8_WAIT_L(0); PG8_MMA(0, 1, At, B1); PG8_BAR;
            PG8_LDA(At, 0, 1); PG8_STAGE(PG8_SA(0, 0), a2, voffA);
            PG8_BAR; PG8_WAIT_L(0); PG8_MMA(1, 0, At, B0); PG8_BAR; PG8_SCHED;
            PG8_STAGE(PG8_SB(0, 1), b2 + hstep, voffB);
            PG8_WAIT_V(6); PG8_BAR; PG8_MMA(1, 1, At, B1); PG8_BAR;
            PG8_LDB(B0, 1, 0); PG8_SCHED; PG8_LDA(At, 1, 0); PG8_STAGE(PG8_SA(0, 1), a2 + hstep, voffA);
            PG8_WAIT_L(8); PG8_BAR; PG8_WAIT_L(0); PG8_MMA(0, 0, At, B0); PG8_BAR; PG8_SCHED;
            PG8_LDB(B1, 1, 1); PG8_STAGE(PG8_SB(1, 0), b3, voffB);
            PG8_BAR; PG8_WAIT_L(0); PG8_MMA(0, 1, At, B1); PG8_BAR;
            PG8_LDA(At, 1, 1); PG8_STAGE(PG8_SA(1, 0), a3, voffA);
            PG8_BAR; PG8_WAIT_L(0); PG8_MMA(1, 0, At, B0); PG8_BAR; PG8_SCHED;
            PG8_STAGE(PG8_SB(1, 1), b3 + hstep, voffB);
            PG8_WAIT_V(6); PG8_BAR; PG8_MMA(1, 1, At, B1); PG8_BAR;
            }
        }
        if constexpr (ALIGN_EPI) { if (wr == 0) PG8_BAR; }
        if constexpr (!Epi::AFTER_DRAIN) { E(acc, cur, wr, wc, fr, fq); S.done(cur); }
        if (!has_next) break;
#pragma unroll
        for (int a = 0; a < 2; ++a)
#pragma unroll
            for (int b = 0; b < 2; ++b)
#pragma unroll
                for (int m = 0; m < 4; ++m)
#pragma unroll
                    for (int n = 0; n < 2; ++n) acc[a][b][m][n] = (f32x4){0.f, 0.f, 0.f, 0.f};
        cur = nxt; cA = nA; cB = nB; ++ui;
        if constexpr (ALIGN_EPI) { if (wr == 1) PG8_BAR; }
    }
    PG8_WAIT_V(0);
    if constexpr (!ALIGN_EPI) { if (wr == 0) PG8_BAR; }
    PG8_BAR;
    if constexpr (Epi::AFTER_DRAIN) { E.fused(acc, cur, wr, wc, fr, fq, lds, wid, lane); S.done(cur); }
#undef PG8_SA
#undef PG8_SB
#undef PG8_STAGE
#undef PG8_LDA
#undef PG8_LDB
#undef PG8_MMA
#undef PG8_WAIT_V
#undef PG8_WAIT_L
#undef PG8_BAR
#undef PG8_SCHED
}
}

#define LAS __attribute__((address_space(3)))
typedef unsigned short bf16;
typedef short bf16x8 __attribute__((ext_vector_type(8)));
typedef float f32x4 __attribute__((ext_vector_type(4)));
typedef unsigned u32x4 __attribute__((ext_vector_type(4)));
typedef unsigned u32x2 __attribute__((ext_vector_type(2)));
using pg8::cvt_pk_bf16;
using pg8::fsigmoid;

#ifndef HG_SCALE
#define HG_SCALE 1.0f
#endif
#ifndef LR_SCALE
#define LR_SCALE 1.0f
#endif
#ifndef SG_SCALE
#define SG_SCALE 1.0f
#endif
#ifndef GEMM_MASK
#define GEMM_MASK 0
#endif
constexpr int NWAVES = 8, NTHREADS = 512;
constexpr int DEPTH = 4, BATCH = 8, SEQ = 4096, D = 1024, T = BATCH * SEQ, FF = 2816, DIN = 3072;
constexpr float EPS = 1e-6f;
constexpr int LDS_BYTES = 147456;
constexpr int ZQ = 0, ZF = 512, ZI = 1024, ZG = 1536, ZX = 2048, ZGATE = 2304, ZU = 2560, ZV = 2816;
constexpr size_t MiB = 1u << 20;
constexpr size_t W_GU = (size_t)2 * FF * D * 2, W_D = (size_t)D * FF * 2, W_IN = (size_t)DIN * D * 2, W_OUT = (size_t)D * D * 2;
constexpr size_t OFF_GU1 = 0, OFF_D1 = OFF_GU1 + W_GU, OFF_IN = OFF_D1 + W_D, OFF_OUT = OFF_IN + W_IN, OFF_GU2 = OFF_OUT + W_OUT, OFF_D2 = OFF_GU2 + W_GU, W_LAYER = OFF_D2 + W_D;
constexpr size_t WS_W = 1 * MiB, WS_XN = WS_W + DEPTH * W_LAYER, WS_Z = WS_XN + (size_t)T * D * 2, WS_HS = WS_Z + (size_t)T * DIN * 2, WS_HD = WS_HS + (size_t)256 * 65536, WS_LE = WS_HD + 256 * 512, WS_LH = WS_LE + 256 * 512, WS_LP = WS_LH + (size_t)T * 256 * 4, WS_END = WS_LP + (size_t)T * 256 * 4;

struct Args { const float* in[26]; float* out; unsigned char* ws; };
typedef const Args __attribute__((address_space(4))) CArgs;
enum { I_X = 0, I_F1N, I_F1G, I_F1U, I_F1D, I_MIXN, I_WIN, I_LB, I_HN, I_CW, I_CB, I_WA, I_BA, I_WX, I_BX, I_LAM, I_LN, I_SW, I_SB, I_SN, I_WOUT, I_F2N, I_F2G, I_F2U, I_F2D, I_FN };

__device__ __forceinline__ float bf2f(unsigned short h) { return __uint_as_float((unsigned)h << 16); }
__device__ __forceinline__ unsigned short f2bf(float f) { return (unsigned short)(cvt_pk_bf16(f, 0.f) & 0xffffu); }
__device__ __forceinline__ float gelu_t(float x) { return x * fsigmoid(1.5957691216f * (x + 0.044715f * x * x * x)); }
__device__ __forceinline__ float silu_f(float x) { return x * fsigmoid(x); }
__device__ __forceinline__ float wave_sum(float v) {
#pragma unroll
    for (int o = 1; o < 64; o <<= 1) v += __shfl_xor(v, o);
    return v;
}
#define BLOCK_SYNC() do { asm volatile("s_waitcnt lgkmcnt(0)" ::: "memory"); __builtin_amdgcn_s_barrier(); asm volatile("" ::: "memory"); } while (0)
__device__ __forceinline__ int opaque_tid() { int t = threadIdx.x; asm volatile("" : "+v"(t)); return t; }

__device__ __forceinline__ void transpose_item(const float* W, int K, int N, bf16* WT, int k0, int n0, int drow0, LAS float* scr, int lane) {
#pragma unroll 8
    for (int i = 0; i < 32; ++i) { const int kk = 2 * i + (lane >> 5); scr[kk * 33 + (lane & 31)] = W[(size_t)(k0 + kk) * N + n0 + (lane & 31)]; }
    asm volatile("s_waitcnt lgkmcnt(0)" ::: "memory");
    const int c = lane & 7;
#pragma unroll
    for (int j = 0; j < 4; ++j) { const int n = (lane >> 3) + 8 * j; const LAS float* s = scr + (8 * c) * 33 + n;
        u32x4 o; o.x = cvt_pk_bf16(s[0 * 33], s[1 * 33]); o.y = cvt_pk_bf16(s[2 * 33], s[3 * 33]); o.z = cvt_pk_bf16(s[4 * 33], s[5 * 33]); o.w = cvt_pk_bf16(s[6 * 33], s[7 * 33]);
        *(u32x4*)(WT + (size_t)(drow0 + n) * K + k0 + 8 * c) = o; }
    asm volatile("s_waitcnt lgkmcnt(0)" ::: "memory");
}
__device__ __forceinline__ void convert_weights(CArgs& a, LAS unsigned char* lds, int gw, int NGW, int wave, int lane) {
    LAS float* scr = (LAS float*)(lds + wave * 16384);
    constexpr int I_FFU = (D / 64) * (FF / 32), I_FFD = (FF / 64) * (D / 32), I_IN_ = (D / 64) * (DIN / 32), I_OUT_ = (D / 64) * (D / 32);
    constexpr int PER_LAYER = 4 * I_FFU + 2 * I_FFD + I_IN_ + I_OUT_;
    for (int it = gw; it < DEPTH * PER_LAYER; it += NGW) {
        const int layer = it / PER_LAYER; int r = it % PER_LAYER;
        bf16* wl = (bf16*)(a.ws + WS_W + (size_t)layer * W_LAYER);
        const float* src; int K, N; bf16* dst; int mode = 0;
        if (r < I_FFU) { src = a.in[I_F1G] + (size_t)layer * D * FF; K = D; N = FF; dst = wl + OFF_GU1 / 2; mode = 1; }
        else if ((r -= I_FFU) < I_FFU) { src = a.in[I_F1U] + (size_t)layer * D * FF; K = D; N = FF; dst = wl + OFF_GU1 / 2; mode = 2; }
        else if ((r -= I_FFU) < I_FFD) { src = a.in[I_F1D] + (size_t)layer * D * FF; K = FF; N = D; dst = wl + OFF_D1 / 2; }
        else if ((r -= I_FFD) < I_IN_) { src = a.in[I_WIN] + (size_t)layer * D * DIN; K = D; N = DIN; dst = wl + OFF_IN / 2; }
        else if ((r -= I_IN_) < I_OUT_) { src = a.in[I_WOUT] + (size_t)layer * D * D; K = D; N = D; dst = wl + OFF_OUT / 2; }
        else if ((r -= I_OUT_) < I_FFU) { src = a.in[I_F2G] + (size_t)layer * D * FF; K = D; N = FF; dst = wl + OFF_GU2 / 2; mode = 1; }
        else if ((r -= I_FFU) < I_FFU) { src = a.in[I_F2U] + (size_t)layer * D * FF; K = D; N = FF; dst = wl + OFF_GU2 / 2; mode = 2; }
        else { r -= I_FFU; src = a.in[I_F2D] + (size_t)layer * D * FF; K = FF; N = D; dst = wl + OFF_D2 / 2; }
        const int nblk = N / 32, kb = r / nblk, nb = r % nblk, n0 = 32 * nb;
        const int drow0 = mode == 0 ? n0 : ((n0 >> 7) * 256 + (n0 & 127) + (mode == 2 ? 128 : 0));
        transpose_item(src, K, N, dst, 64 * kb, n0, drow0, scr, lane);
    }
}
template <bool HB, bool FINAL>
__device__ __forceinline__ void norm_rows(const void* src, const bf16* y, float ys, bf16* hdst, const float* gain, bf16* xn, float* fout, float* fstage, int gw, int NGW, int lane) {
    f32x4 gv[4];
#pragma unroll
    for (int j = 0; j < 4; ++j) gv[j] = ((const f32x4*)gain)[lane + 64 * j];
    for (int m0 = gw; m0 < T; m0 += 2 * NGW) {
        f32x4 v[2][4]; u32x2 yw[2][4];
#pragma unroll
        for (int r = 0; r < 2; ++r) { const int m = m0 + r * NGW;
            if (HB) { const u32x2* hr = (const u32x2*)((const bf16*)src + (size_t)m * D) + lane;
#pragma unroll
                for (int j = 0; j < 4; ++j) { const u32x2 w = hr[64 * j]; v[r][j] = (f32x4){__uint_as_float(w.x << 16), __uint_as_float(w.x & 0xffff0000u), __uint_as_float(w.y << 16), __uint_as_float(w.y & 0xffff0000u)}; }
            } else { const f32x4* xr = (const f32x4*)((const float*)src + (size_t)m * D) + lane;
#pragma unroll
                for (int j = 0; j < 4; ++j) v[r][j] = xr[64 * j]; }
            if (y) { const u32x2* yr = (const u32x2*)(y + (size_t)m * D) + lane;
#pragma unroll
                for (int j = 0; j < 4; ++j) yw[r][j] = yr[64 * j]; } }
        float s[2];
#pragma unroll
        for (int r = 0; r < 2; ++r) { s[r] = 0.f;
            if (y) {
#pragma unroll
                for (int j = 0; j < 4; ++j) { const u32x2 w = yw[r][j];
                    v[r][j].x += ys * __uint_as_float(w.x << 16); v[r][j].y += ys * __uint_as_float(w.x & 0xffff0000u); v[r][j].z += ys * __uint_as_float(w.y << 16); v[r][j].w += ys * __uint_as_float(w.y & 0xffff0000u); } }
#pragma unroll
            for (int j = 0; j < 4; ++j) s[r] += (v[r][j].x * v[r][j].x + v[r][j].y * v[r][j].y) + (v[r][j].z * v[r][j].z + v[r][j].w * v[r][j].w); }
#pragma unroll
        for (int o = 1; o < 64; o <<= 1) { s[0] += __shfl_xor(s[0], o); s[1] += __shfl_xor(s[1], o); }
#pragma unroll
        for (int r = 0; r < 2; ++r) { const int m = m0 + r * NGW; const float rstd = rsqrtf(s[r] * (1.f / D) + EPS);
            if (!FINAL && hdst) { u32x2* hr = (u32x2*)(hdst + (size_t)m * D) + lane;
#pragma unroll
                for (int j = 0; j < 4; ++j) { u32x2 w; w.x = cvt_pk_bf16(v[r][j].x, v[r][j].y); w.y = cvt_pk_bf16(v[r][j].z, v[r][j].w); hr[64 * j] = w; } }
            if (FINAL) { f32x4* o = (f32x4*)((m >= T / 2 ? fout : fstage) + (size_t)m * D) + lane;
#pragma unroll
                for (int j = 0; j < 4; ++j) o[64 * j] = v[r][j] * rstd * gv[j];
            } else { u32x2* o = (u32x2*)(xn + (size_t)m * D) + lane;
#pragma unroll
                for (int j = 0; j < 4; ++j) { const f32x4 q = v[r][j] * rstd * gv[j]; u32x2 w; w.x = cvt_pk_bf16(q.x, q.y); w.y = cvt_pk_bf16(q.z, q.w); o[64 * j] = w; } } }
    }
}
__device__ __forceinline__ void copy_rows(const float* st, float* out, int gw, int NGW, int lane) {
    for (int m = gw; m < T / 2; m += NGW) { const f32x4* a = (const f32x4*)(st + (size_t)m * D) + lane; f32x4* o = (f32x4*)(out + (size_t)m * D) + lane;
        f32x4 v[4];
#pragma unroll
        for (int j = 0; j < 4; ++j) v[j] = a[64 * j];
#pragma unroll
        for (int j = 0; j < 4; ++j) o[64 * j] = v[j]; }
}

template <int KSTEPS>
__device__ __forceinline__ f32x4 mma16(const LAS bf16* A, int lda, const LAS bf16* B, int ldb, f32x4 acc, int fr, int fq) {
    const LAS bf16* ap = A + fr * lda + fq * 8; const LAS bf16* bp = B + fr * ldb + fq * 8;
#pragma unroll
    for (int kk = 0; kk < KSTEPS; ++kk) {
        const bf16x8 av = *(const LAS bf16x8*)(ap + kk * 32); const bf16x8 bv = *(const LAS bf16x8*)(bp + kk * 32);
        acc = __builtin_amdgcn_mfma_f32_16x16x32_bf16(bv, av, acc, 0, 0, 0);
    }
    return acc;
}

constexpr int QLD = 136, SLD = 72;
constexpr int NSEG = 8, SEG_CHUNKS = SEQ / 64 / NSEG;
template <bool FULL>
__device__ __forceinline__ void hgrn_seg(CArgs& a, LAS unsigned char* lds, int layer, int item, const bf16* z, bf16* mix, float* HS, float* HD) {
    const int tid = opaque_tid(), lane = tid & 63, wave = tid >> 6, fr = lane & 15, fq = lane >> 4;
    const int b = item >> 5, hd = (item >> 3) & 3, sgi = item & 7;
    LAS bf16* Q = (LAS bf16*)(lds);
    LAS bf16* Kt = (LAS bf16*)(lds + 17408);
    LAS bf16* KsT = (LAS bf16*)(lds + 34816);
    LAS bf16* VT = (LAS bf16*)(lds + 53248);
    LAS bf16* S = (LAS bf16*)(lds + 71680);
    LAS bf16* StT = (LAS bf16*)(lds + 80896);
    LAS float* dk = (LAS float*)(lds + 115712);
    LAS float* seg = (LAS float*)(lds + 116224);
    LAS float* red = (LAS float*)(lds + 118272);
    const int ch = tid & 127, tq = tid >> 7;
    float lb;
    { const float* lg = a.in[I_LB] + hd * 128 + ch; const float l0 = lg[0], l1 = lg[512], l2 = lg[1024], l3 = lg[1536];
      const float mx = fmaxf(fmaxf(l0, l1), fmaxf(l2, l3)); const float e0 = __expf(l0 - mx), e1 = __expf(l1 - mx), e2 = __expf(l2 - mx), e3 = __expf(l3 - mx);
      const float inv = 1.f / (e0 + e1 + e2 + e3); lb = (layer >= 1 ? e1 : 0.f) + (layer >= 2 ? e2 : 0.f) + (layer >= 3 ? e3 : 0.f); lb *= inv; }
    const float oml = 1.f - lb;
    f32x4 st[8];
#pragma unroll
    for (int i = 0; i < 8; ++i) st[i] = (f32x4){0.f, 0.f, 0.f, 0.f};
    if (FULL) {
        for (int j = 0; j < sgi; ++j) { const float* Sj = HS + (size_t)(item - sgi + j) * 16384 + (16 * wave + fr) * 128 + 4 * fq; const float* Dj = HD + (item - sgi + j) * 128 + 4 * fq;
#pragma unroll
            for (int kb = 0; kb < 8; ++kb) st[kb] = st[kb] * *(const f32x4*)(Dj + 16 * kb) + *(const f32x4*)(Sj + 16 * kb); }
#pragma unroll
        for (int kb = 0; kb < 8; ++kb) { u32x2 w; w.x = cvt_pk_bf16(st[kb][0], st[kb][1]); w.y = cvt_pk_bf16(st[kb][2], st[kb][3]);
            *(LAS u32x2*)(StT + (16 * wave + fr) * QLD + 16 * kb + 4 * fq) = w; }
    }
    const int tb = wave & 3, vh = wave >> 2;
    const float* gn = a.in[I_HN] + layer * 512 + hd * 128;
    float dsum = 1.f;
    f32x4 ggv[4];
    if (FULL) {
#pragma unroll
        for (int i = 0; i < 4; ++i) ggv[i] = *(const f32x4*)(gn + 16 * ((wave >> 2) * 4 + i) + 4 * fq); }
    unsigned short rf[16], rq[16], ri[16];
    const size_t tseg = (size_t)b * SEQ + (size_t)sgi * SEG_CHUNKS * 64;
    { const bf16* zr = z + (tseg + tq * 16) * DIN + hd * 128 + ch;
#pragma unroll
      for (int j = 0; j < 16; ++j) { rf[j] = zr[(size_t)j * DIN + ZF]; ri[j] = zr[(size_t)j * DIN + ZI]; if (FULL) rq[j] = zr[(size_t)j * DIN + ZQ]; } }
    BLOCK_SYNC();
    for (int c = 0; c < SEG_CHUNKS; ++c) {
        const size_t t0 = tseg + c * 64;
        float bl[16], kv[16]; float run = 1.f;
#pragma unroll
        for (int j = 0; j < 16; ++j) { const float x = fminf(fmaxf(bf2f(rf[j]), -30.f), 30.f); const float e = __expf(-x), sg = __builtin_amdgcn_rcpf(1.f + e);
            const float f = lb + oml * sg; run *= f; bl[j] = run; kv[j] = oml * e * sg; }
        seg[tq * 128 + ch] = run;
        BLOCK_SYNC();
        float prefix = 1.f, total = 1.f;
#pragma unroll
        for (int q = 0; q < 4; ++q) { const float sv = seg[q * 128 + ch]; total *= sv; if (q < tq) prefix *= sv; }
        dsum *= total;
        unsigned ksp[8], vip[8];
#pragma unroll
        for (int j = 0; j < 16; j += 2) {
            float ks2[2];
#pragma unroll
            for (int jj = 0; jj < 2; ++jj) { const int t = j + jj; const float e1 = fmaxf(prefix * bl[t], 1e-35f), e2 = __builtin_amdgcn_rcpf(e1);
                if (FULL) { const float qx = bf2f(rq[t]); const float qv = qx * fsigmoid(qx);
                    Q[(tq * 16 + t) * QLD + ch] = f2bf(qv * e1);
                    Kt[(tq * 16 + t) * QLD + ch] = f2bf(kv[t] * e2); }
                ks2[jj] = kv[t] * (total * e2); }
            ksp[j >> 1] = cvt_pk_bf16(ks2[0], ks2[1]); vip[j >> 1] = (unsigned)ri[j] | ((unsigned)ri[j + 1] << 16);
        }
        { LAS u32x4* kp = (LAS u32x4*)(KsT + ch * SLD + tq * 16); kp[0] = (u32x4){ksp[0], ksp[1], ksp[2], ksp[3]}; kp[1] = (u32x4){ksp[4], ksp[5], ksp[6], ksp[7]};
          LAS u32x4* vp = (LAS u32x4*)(VT + ch * SLD + tq * 16); vp[0] = (u32x4){vip[0], vip[1], vip[2], vip[3]}; vp[1] = (u32x4){vip[4], vip[5], vip[6], vip[7]}; }
        if (tq == 0) dk[ch] = total;
        if (c + 1 < SEG_CHUNKS) { const bf16* zr = z + (t0 + 64 + tq * 16) * DIN + hd * 128 + ch;
#pragma unroll
            for (int j = 0; j < 16; ++j) { rf[j] = zr[(size_t)j * DIN + ZF]; ri[j] = zr[(size_t)j * DIN + ZI]; if (FULL) rq[j] = zr[(size_t)j * DIN + ZQ]; } }
        u32x2 gwv[4];
        if (FULL) { const bf16* gr = z + (t0 + 16 * tb + fr) * DIN + ZG + hd * 128;
#pragma unroll
            for (int i = 0; i < 4; ++i) gwv[i] = *(const u32x2*)(gr + 16 * (vh * 4 + i) + 4 * fq); }
        BLOCK_SYNC();
        if (FULL) {
#pragma unroll
        for (int i = 0; i < 2; ++i) { const int sb = vh * 2 + i;
            f32x4 acc = (f32x4){0.f, 0.f, 0.f, 0.f};
            if (sb <= tb) acc = mma16<4>(Q + 16 * tb * QLD, QLD, Kt + 16 * sb * QLD, QLD, acc, fr, fq);
            const int t = 16 * tb + fr, s0 = 16 * sb + 4 * fq;
            u32x2 w; w.x = cvt_pk_bf16(s0 <= t ? acc[0] : 0.f, s0 + 1 <= t ? acc[1] : 0.f); w.y = cvt_pk_bf16(s0 + 2 <= t ? acc[2] : 0.f, s0 + 3 <= t ? acc[3] : 0.f);
            *(LAS u32x2*)(S + t * SLD + s0) = w; }
        BLOCK_SYNC();
        f32x4 o[4]; float ss = 0.f;
#pragma unroll
        for (int i = 0; i < 4; ++i) { const int vb = vh * 4 + i;
            f32x4 acc = (f32x4){0.f, 0.f, 0.f, 0.f};
            acc = mma16<2>(S + 16 * tb * SLD, SLD, VT + 16 * vb * SLD, SLD, acc, fr, fq);
            acc = mma16<4>(Q + 16 * tb * QLD, QLD, StT + 16 * vb * QLD, QLD, acc, fr, fq);
            o[i] = acc; ss += (acc[0] * acc[0] + acc[1] * acc[1]) + (acc[2] * acc[2] + acc[3] * acc[3]); }
        ss += __shfl_xor(ss, 16); ss += __shfl_xor(ss, 32);
        if (fq == 0) red[vh * 64 + 16 * tb + fr] = ss;
        BLOCK_SYNC();
        { const int t = 16 * tb + fr; const float rs = rsqrtf((red[t] + red[64 + t]) * (1.f / 128.f) + EPS);
          bf16* mr = mix + (t0 + t) * D + hd * 128;
#pragma unroll
          for (int i = 0; i < 4; ++i) { const int v0 = 16 * (vh * 4 + i) + 4 * fq;
              const u32x2 gw = gwv[i]; const f32x4 gg = ggv[i];
              const float g0 = __uint_as_float(gw.x << 16), g1 = __uint_as_float(gw.x & 0xffff0000u), g2 = __uint_as_float(gw.y << 16), g3 = __uint_as_float(gw.y & 0xffff0000u);
              u32x2 w; w.x = cvt_pk_bf16(o[i][0] * rs * gg[0] * silu_f(g0), o[i][1] * rs * gg[1] * silu_f(g1));
              w.y = cvt_pk_bf16(o[i][2] * rs * gg[2] * silu_f(g2), o[i][3] * rs * gg[3] * silu_f(g3));
              *(u32x2*)(mr + v0) = w; } }
        }
#pragma unroll
        for (int kb = 0; kb < 8; ++kb) { const f32x4 d4 = *(const LAS f32x4*)(dk + 16 * kb + 4 * fq);
            st[kb] = st[kb] * d4;
            st[kb] = mma16<2>(VT + 16 * wave * SLD, SLD, KsT + 16 * kb * SLD, SLD, st[kb], fr, fq);
            if (FULL) { u32x2 w; w.x = cvt_pk_bf16(st[kb][0], st[kb][1]); w.y = cvt_pk_bf16(st[kb][2], st[kb][3]);
                *(LAS u32x2*)(StT + (16 * wave + fr) * QLD + 16 * kb + 4 * fq) = w; } }
        BLOCK_SYNC();
    }
    if (!FULL) {
        float* So = HS + (size_t)item * 16384 + (16 * wave + fr) * 128 + 4 * fq;
#pragma unroll
        for (int kb = 0; kb < 8; ++kb) *(f32x4*)(So + 16 * kb) = st[kb];
        if (tq == 0) HD[item * 128 + ch] = dsum;
    }
}

__device__ __forceinline__ void lru_pass1(CArgs& a, LAS unsigned char* lds, int layer, int item, const bf16* z, float* LH, float* LP, float* LE) {
    const int tid = opaque_tid(), lane = tid & 63, wave = tid >> 6, fr = lane & 15, fq = lane >> 4;
    const int b = item >> 5, blk = (item >> 3) & 3, sgi = item & 7;
    LAS bf16* WaT = (LAS bf16*)(lds);
    LAS bf16* WxT = (LAS bf16*)(lds + 9216);
    LAS bf16* XC = (LAS bf16*)(lds + 18432);
    LAS float* XCf = (LAS float*)(lds + 27648);
    LAS float* Af = (LAS float*)(lds + 44032);
    LAS float* Uf = (LAS float*)(lds + 60416);
    LAS float* segP = (LAS float*)(lds + 76800);
    LAS float* segH = (LAS float*)(lds + 78848);
    LAS float* carry = (LAS float*)(lds + 80896);
    const int cbase = blk * 64;
    { const float* wa = a.in[I_WA] + ((size_t)layer * 4 + blk) * 4096; const float* wx = a.in[I_WX] + ((size_t)layer * 4 + blk) * 4096;
      for (int e = tid; e < 4096; e += NTHREADS) { const int i = e >> 6, j = e & 63; WaT[j * SLD + i] = f2bf(wa[e]); WxT[j * SLD + i] = f2bf(wx[e]); } }
    if (tid < 64) { carry[tid] = 0.f; carry[64 + tid] = 1.f; }
    const int ct = tid >> 3, c8 = (tid & 7) * 8;
    float cw[4][8], cb[8];
#pragma unroll
    for (int k = 0; k < 8; ++k) { cb[k] = a.in[I_CB][layer * 256 + cbase + c8 + k];
#pragma unroll
        for (int tap = 0; tap < 4; ++tap) cw[tap][k] = a.in[I_CW][(layer * 4 + tap) * 256 + cbase + c8 + k]; }
    const int tb = wave & 3, jh = wave >> 2;
    float gba[2][4], gbx[2][4], gsp[2][4];
#pragma unroll
    for (int i = 0; i < 2; ++i)
#pragma unroll
        for (int j = 0; j < 4; ++j) { const int col = 16 * (jh * 2 + i) + 4 * fq + j;
            gba[i][j] = a.in[I_BA][layer * 256 + cbase + col]; gbx[i][j] = a.in[I_BX][layer * 256 + cbase + col];
            const float lam = a.in[I_LAM][layer * 256 + cbase + col]; gsp[i][j] = log1pf(__expf(-lam)); }
    const int tl0 = sgi * 512;
    u32x4 xv[4];
#pragma unroll
    for (int tap = 0; tap < 4; ++tap) { const int tt = tl0 + ct + tap - 3; xv[tap] = (u32x4){0u, 0u, 0u, 0u};
        if (tt >= 0) xv[tap] = *(const u32x4*)(z + ((size_t)b * SEQ + tt) * DIN + ZX + cbase + c8); }
    BLOCK_SYNC();
    for (int c = 0; c < 8; ++c) {
        const size_t t0 = (size_t)b * SEQ + tl0 + c * 64;
        { float xc[8];
#pragma unroll
          for (int k = 0; k < 8; ++k) xc[k] = cb[k];
#pragma unroll
          for (int tap = 0; tap < 4; ++tap)
#pragma unroll
              for (int k = 0; k < 4; ++k) { xc[2 * k] += cw[tap][2 * k] * __uint_as_float(xv[tap][k] << 16); xc[2 * k + 1] += cw[tap][2 * k + 1] * __uint_as_float(xv[tap][k] & 0xffff0000u); }
          u32x4 w; w.x = cvt_pk_bf16(xc[0], xc[1]); w.y = cvt_pk_bf16(xc[2], xc[3]); w.z = cvt_pk_bf16(xc[4], xc[5]); w.w = cvt_pk_bf16(xc[6], xc[7]);
          *(LAS u32x4*)(XC + ct * SLD + c8) = w;
          *(LAS f32x4*)(XCf + ct * 64 + c8) = (f32x4){xc[0], xc[1], xc[2], xc[3]}; *(LAS f32x4*)(XCf + ct * 64 + c8 + 4) = (f32x4){xc[4], xc[5], xc[6], xc[7]}; }
        if (c + 1 < 8) {
#pragma unroll
            for (int tap = 0; tap < 4; ++tap) xv[tap] = *(const u32x4*)(z + (t0 + 64 + ct + tap - 3) * DIN + ZX + cbase + c8); }
        BLOCK_SYNC();
#pragma unroll
        for (int i = 0; i < 2; ++i) { const int jb = jh * 2 + i; const f32x4 zero = (f32x4){0.f, 0.f, 0.f, 0.f};
            const f32x4 ga = mma16<2>(XC + 16 * tb * SLD, SLD, WaT + 16 * jb * SLD, SLD, zero, fr, fq);
            const f32x4 gx = mma16<2>(XC + 16 * tb * SLD, SLD, WxT + 16 * jb * SLD, SLD, zero, fr, fq);
            const int t = 16 * tb + fr, col0 = 16 * jb + 4 * fq;
            const f32x4 xcv = *(const LAS f32x4*)(XCf + t * 64 + col0);
            f32x4 av, uv;
#pragma unroll
            for (int j = 0; j < 4; ++j) { const float r = fsigmoid(ga[j] + gba[i][j]), gi = fsigmoid(gx[j] + gbx[i][j]);
                const float la = -8.0f * r * gsp[i][j]; av[j] = __expf(la); uv[j] = __builtin_amdgcn_sqrtf(fmaxf(1.f - av[j] * av[j], 0.f)) * gi * xcv[j]; }
            *(LAS f32x4*)(Af + t * 64 + col0) = av; *(LAS f32x4*)(Uf + t * 64 + col0) = uv; }
        BLOCK_SYNC();
        { float av[8], uv[8]; float P = 1.f, H = 0.f;
#pragma unroll
          for (int k = 0; k < 8; ++k) { av[k] = Af[(wave * 8 + k) * 64 + lane]; uv[k] = Uf[(wave * 8 + k) * 64 + lane]; H = av[k] * H + uv[k]; P *= av[k]; }
          segP[wave * 64 + lane] = P; segH[wave * 64 + lane] = H;
          BLOCK_SYNC();
          float h = carry[lane], p = carry[64 + lane];
          for (int q = 0; q < wave; ++q) { const float sp = segP[q * 64 + lane]; h = sp * h + segH[q * 64 + lane]; p *= sp; }
          float* lh = LH + (t0 + wave * 8) * 256 + cbase + lane; float* lp = LP + (t0 + wave * 8) * 256 + cbase + lane;
#pragma unroll
          for (int k = 0; k < 8; ++k) { h = av[k] * h + uv[k]; p *= av[k]; lh[k * 256] = h; lp[k * 256] = p; }
          BLOCK_SYNC();
          if (wave == 7) { carry[lane] = h; carry[64 + lane] = p; } }
    }
    BLOCK_SYNC();
    if (tid < 64) { LE[item * 128 + tid] = carry[64 + tid]; LE[item * 128 + 64 + tid] = carry[tid]; }
    BLOCK_SYNC();
}
__device__ __forceinline__ void lru_pass2(CArgs& a, LAS unsigned char* lds, int layer, int bx, const bf16* z, bf16* mix, const float* LH, const float* LP, const float* LE) {
    const int tid = opaque_tid();
    const int b = bx >> 5, sgi = (bx >> 2) & 7;
    const int tl = tid >> 3, c8 = (tid & 7) * 8;
    LAS float* cinl = (LAS float*)lds;
    if (tid < 256) { const float* le = LE + (size_t)((b * 4 + (tid >> 6)) * 8) * 128 + (tid & 63);
        float P[7], H[7];
#pragma unroll
        for (int j = 0; j < 7; ++j) { P[j] = 0.f; H[j] = 0.f; if (j < sgi) { P[j] = le[j * 128]; H[j] = le[j * 128 + 64]; } }
        float c = 0.f;
#pragma unroll
        for (int j = 0; j < 7; ++j) if (j < sgi) c = P[j] * c + H[j];
        cinl[tid] = c; }
    BLOCK_SYNC();
#pragma unroll 1
    for (int blk = 0; blk < 4; ++blk) {
        const f32x4 ci0 = *(const LAS f32x4*)(cinl + blk * 64 + c8), ci1 = *(const LAS f32x4*)(cinl + blk * 64 + c8 + 4);
        const float cin[8] = {ci0[0], ci0[1], ci0[2], ci0[3], ci1[0], ci1[1], ci1[2], ci1[3]};
        const float* ng = a.in[I_LN] + layer * 256 + blk * 64 + c8;
        const f32x4 g0 = *(const f32x4*)ng, g1 = *(const f32x4*)(ng + 4);
        f32x4 h0[2], h1[2], p0[2], p1[2]; u32x4 gv[2];
#pragma unroll
        for (int hh = 0; hh < 2; ++hh) { const size_t t = (size_t)bx * 128 + hh * 64 + tl;
            const float* lh = LH + t * 256 + blk * 64 + c8; const float* lp = LP + t * 256 + blk * 64 + c8;
            h0[hh] = *(const f32x4*)lh; h1[hh] = *(const f32x4*)(lh + 4); p0[hh] = *(const f32x4*)lp; p1[hh] = *(const f32x4*)(lp + 4);
            gv[hh] = *(const u32x4*)(z + t * DIN + ZGATE + blk * 64 + c8); }
#pragma unroll
        for (int hh = 0; hh < 2; ++hh) { const size_t t = (size_t)bx * 128 + hh * 64 + tl;
            float y[8]; float ss = 0.f;
#pragma unroll
            for (int k = 0; k < 4; ++k) { const float ge = __uint_as_float(gv[hh][k] << 16), go = __uint_as_float(gv[hh][k] & 0xffff0000u);
                const float he = (k < 2 ? h0[hh][2 * k] : h1[hh][2 * k - 4]) + (k < 2 ? p0[hh][2 * k] : p1[hh][2 * k - 4]) * cin[2 * k];
                const float ho = (k < 2 ? h0[hh][2 * k + 1] : h1[hh][2 * k - 3]) + (k < 2 ? p0[hh][2 * k + 1] : p1[hh][2 * k - 3]) * cin[2 * k + 1];
                y[2 * k] = he * gelu_t(ge); y[2 * k + 1] = ho * gelu_t(go); ss += y[2 * k] * y[2 * k] + y[2 * k + 1] * y[2 * k + 1]; }
            ss += __shfl_xor(ss, 1); ss += __shfl_xor(ss, 2); ss += __shfl_xor(ss, 4);
            const float rs = rsqrtf(ss * (1.f / 64.f) + EPS);
            u32x4 w; w.x = cvt_pk_bf16(y[0] * rs * g0[0], y[1] * rs * g0[1]); w.y = cvt_pk_bf16(y[2] * rs * g0[2], y[3] * rs * g0[3]);
            w.z = cvt_pk_bf16(y[4] * rs * g1[0], y[5] * rs * g1[1]); w.w = cvt_pk_bf16(y[6] * rs * g1[2], y[7] * rs * g1[3]);
            *(u32x4*)(mix + t * D + 512 + blk * 64 + c8) = w; }
    }
    BLOCK_SYNC();
}

__device__ __forceinline__ void sgu_items(CArgs& a, LAS unsigned char* lds, int layer, int first, int stride, const bf16* z, bf16* mix) {
    const int tid = opaque_tid(), lane = tid & 63, wave = tid >> 6, fr = lane & 15, fq = lane >> 4;
    LAS bf16* Wm = (LAS bf16*)(lds);
    LAS bf16* VnT = (LAS bf16*)(lds + 34816);
    int cur_grp = -1;
    for (int it = first; it < BATCH * 32 * 4; it += stride) {
        const int grp = it & 3, bn = it >> 2; const size_t t0 = (size_t)bn * 128;
        if (grp != cur_grp) { cur_grp = grp;
            const float* ws = a.in[I_SW] + ((size_t)layer * 4 + grp) * 16384;
            for (int e = tid; e < 4096; e += NTHREADS) { const int t = e >> 5, s0 = (e & 31) * 4; const f32x4 wv = *(const f32x4*)(ws + t * 128 + s0);
                u32x2 w; w.x = cvt_pk_bf16(s0 <= t ? wv[0] : 0.f, s0 + 1 <= t ? wv[1] : 0.f); w.y = cvt_pk_bf16(s0 + 2 <= t ? wv[2] : 0.f, s0 + 3 <= t ? wv[3] : 0.f);
                *(LAS u32x2*)(Wm + t * QLD + s0) = w; } }
        { const int s = tid >> 2, cq = tid & 3; const bf16* vr = z + (t0 + s) * DIN + ZV + grp * 64 + cq * 16;
          const u32x4 r0 = *(const u32x4*)vr, r1 = *(const u32x4*)(vr + 8);
          float v[16]; float sum = 0.f;
#pragma unroll
          for (int k = 0; k < 4; ++k) { v[2 * k] = gelu_t(__uint_as_float(r0[k] << 16)); v[2 * k + 1] = gelu_t(__uint_as_float(r0[k] & 0xffff0000u));
              v[8 + 2 * k] = gelu_t(__uint_as_float(r1[k] << 16)); v[8 + 2 * k + 1] = gelu_t(__uint_as_float(r1[k] & 0xffff0000u)); }
#pragma unroll
          for (int k = 0; k < 16; ++k) sum += v[k];
          sum += __shfl_xor(sum, 1); sum += __shfl_xor(sum, 2);
          const float mu = sum * (1.f / 64.f); float sq = 0.f;
#pragma unroll
          for (int k = 0; k < 16; ++k) { v[k] -= mu; sq += v[k] * v[k]; }
          sq += __shfl_xor(sq, 1); sq += __shfl_xor(sq, 2);
          const float rs = rsqrtf(sq * (1.f / 64.f) + EPS);
#pragma unroll
          for (int k = 0; k < 16; ++k) VnT[(cq * 16 + k) * QLD + s] = f2bf(v[k] * rs); }
        BLOCK_SYNC();
        { const int t = 16 * wave + fr; f32x4 y[4]; float ss = 0.f;
          const float bias = a.in[I_SB][((size_t)layer * 4 + grp) * 128 + t];
          const bf16* ur = z + (t0 + t) * DIN + ZU + grp * 64;
#pragma unroll
          for (int cb = 0; cb < 4; ++cb) { f32x4 acc = (f32x4){0.f, 0.f, 0.f, 0.f};
              acc = mma16<4>(Wm + 16 * wave * QLD, QLD, VnT + 16 * cb * QLD, QLD, acc, fr, fq);
              const u32x2 uw = *(const u32x2*)(ur + 16 * cb + 4 * fq);
              const float u0 = __uint_as_float(uw.x << 16), u1 = __uint_as_float(uw.x & 0xffff0000u), u2 = __uint_as_float(uw.y << 16), u3 = __uint_as_float(uw.y & 0xffff0000u);
              y[cb] = (f32x4){gelu_t(u0) * (acc[0] + bias), gelu_t(u1) * (acc[1] + bias), gelu_t(u2) * (acc[2] + bias), gelu_t(u3) * (acc[3] + bias)};
              ss += (y[cb][0] * y[cb][0] + y[cb][1] * y[cb][1]) + (y[cb][2] * y[cb][2] + y[cb][3] * y[cb][3]); }
          ss += __shfl_xor(ss, 16); ss += __shfl_xor(ss, 32);
          const float rs = SG_SCALE * rsqrtf(ss * (1.f / 64.f) + EPS);
          const float* ng = a.in[I_SN] + layer * 256 + grp * 64; bf16* mr = mix + (t0 + t) * D + 768 + grp * 64;
#pragma unroll
          for (int cb = 0; cb < 4; ++cb) { const f32x4 gg = *(const f32x4*)(ng + 16 * cb + 4 * fq);
              u32x2 w; w.x = cvt_pk_bf16(y[cb][0] * rs * gg[0], y[cb][1] * rs * gg[1]); w.y = cvt_pk_bf16(y[cb][2] * rs * gg[2], y[cb][3] * rs * gg[3]);
              *(u32x2*)(mr + 16 * cb + 4 * fq) = w; } }
        BLOCK_SYNC();
    }
}

#define XB_TMO      128
#define XB_XCNT(j)  (256  + 64 * (j))
#define XB_XSUB(j)  (1280 + 64 * (j))
#define XB_XGEN(j)  (2304 + 64 * (j))
#define XB_TOP      3328
#define XB_TOPGEN   3392
#define XCD_BAR_WORDS 3456
#define XB_SPIN_CAP (1u << 18)

__device__ __forceinline__ unsigned xb_ld(unsigned* p)              { return __hip_atomic_load(p, __ATOMIC_RELAXED, __HIP_MEMORY_SCOPE_AGENT); }
__device__ __forceinline__ unsigned xb_add(unsigned* p, unsigned v) { return __hip_atomic_fetch_add(p, v, __ATOMIC_RELAXED, __HIP_MEMORY_SCOPE_AGENT); }
__device__ __forceinline__ unsigned xb_xcc_id() { return (unsigned)__builtin_amdgcn_s_getreg((3 << 11) | 20) & 0xFu; }
#define XB_SPIN(cond, bar) do { unsigned _sp = 0; while (cond) { __builtin_amdgcn_s_sleep(1); \
    if ((++_sp & 255u) == 0u) { if (xb_ld(&(bar)[XB_TMO])) break; if (_sp > XB_SPIN_CAP) { atomicAdd(&(bar)[XB_TMO], 1u); break; } } } } while (0)

struct XcdBarrier {
    unsigned* bar; unsigned x;
    volatile LAS unsigned* st;
};

__device__ __forceinline__ XcdBarrier xcd_barrier_post(unsigned* bar, volatile LAS unsigned* st) {
    XcdBarrier b; b.bar = bar; b.x = xb_xcc_id(); b.st = st;
    if (threadIdx.x == 0) (void)xb_add(&bar[XB_XCNT(b.x)], 1u);
    return b;
}
__device__ __forceinline__ void xcd_barrier_complete(unsigned* bar, unsigned x, unsigned& nloc, unsigned& nx) {
    const unsigned G = gridDim.x * gridDim.y * gridDim.z;
    unsigned sum, cnt, mine, sp = 0u;
    for (;;) {
        sum = 0u; cnt = 0u; mine = 0u;
#pragma unroll
        for (unsigned j = 0; j < 16; ++j) { const unsigned c = xb_ld(&bar[XB_XCNT(j)]); sum += c; cnt += (c > 0u) ? 1u : 0u; mine = (j == x) ? c : mine; }
        if (sum == G) break;
        __builtin_amdgcn_s_sleep(1);
        if ((++sp & 255u) == 0u) { if (xb_ld(&bar[XB_TMO])) break; if (sp > XB_SPIN_CAP) { atomicAdd(&bar[XB_TMO], 1u); break; } }
    }
    nloc = mine > 0u ? mine : 1u; nx = cnt > 0u ? cnt : 1u;
}

__device__ __forceinline__ void xcd_barrier(const XcdBarrier& b) {
    asm volatile("s_waitcnt vmcnt(0)" ::: "memory");
    __syncthreads();
    if (threadIdx.x == 0) {
        unsigned* bar = b.bar;
        __builtin_amdgcn_s_waitcnt(0);
        unsigned nloc = b.st[0], nx = b.st[1];
        if (nloc == 0u) { xcd_barrier_complete(bar, b.x, nloc, nx); b.st[0] = nloc; b.st[1] = nx; }
        const unsigned old = xb_add(&bar[XB_XSUB(b.x)], 1u);
        const unsigned gen = old / nloc;
        if (old + 1u == (gen + 1u) * nloc) {
            __builtin_amdgcn_fence(__ATOMIC_RELEASE, "agent");
            asm volatile("s_waitcnt vmcnt(0)" ::: "memory");
            const unsigned og = xb_add(&bar[XB_TOP], 1u);
            const unsigned tg = og / nx;
            if (og + 1u == (tg + 1u) * nx) xb_add(&bar[XB_TOPGEN], 1u);
            else XB_SPIN(xb_ld(&bar[XB_TOPGEN]) == tg, bar);
            __builtin_amdgcn_fence(__ATOMIC_ACQUIRE, "agent");
            xb_add(&bar[XB_XGEN(b.x)], 1u);
            asm volatile("s_waitcnt vmcnt(0)" ::: "memory");
        } else {
            XB_SPIN(xb_ld(&bar[XB_XGEN(b.x)]) == gen, bar);
            __builtin_amdgcn_fence(__ATOMIC_ACQUIRE, "agent");
            asm volatile("s_waitcnt vmcnt(0)" ::: "memory");
        }
    }
    __syncthreads();
}

template <class Epi, int ID>
__device__ __forceinline__ void run_gemm(LAS unsigned char* lds, const bf16* A, const bf16* Bt, int N, int K, int G, int bx, const Epi& E) {
#ifndef NO_GEMM
    if (ID & GEMM_MASK) return;
    pg8::Gemm g{A, Bt, T, N, K}; pg8::StaticOrder S; S.init(T, N, G, bx);
    pg8::gemm_phase<Epi, pg8::StaticOrder, true, true>(lds, g, S, E);
#endif
}
__device__ __forceinline__ CArgs* args_ptr() { CArgs* p = (CArgs*)__builtin_amdgcn_kernarg_segment_ptr(); asm volatile("" : "+s"(p)); return p; }
__global__ void __launch_bounds__(NTHREADS, 2) fwd_kernel(Args a_unused) {
    extern __shared__ __attribute__((aligned(16))) unsigned char lds_raw[];
    LAS unsigned char* lds = (LAS unsigned char*)lds_raw;
    cg::grid_group grid = cg::this_grid();
    volatile LAS unsigned* MISC = (volatile LAS unsigned*)(lds + 131072 + 320);
    if (threadIdx.x < 32) MISC[threadIdx.x] = 0u;
    __syncthreads();
    (void)xcd_barrier_post((unsigned*)args_ptr()->ws, MISC + 8);
#define GRID_BAR() do { XcdBarrier b_; b_.bar = (unsigned*)args_ptr()->ws; b_.x = xb_xcc_id(); b_.st = (volatile LAS unsigned*)(lds + 131072 + 320) + 8; xcd_barrier(b_); } while (0)
    const int tid = threadIdx.x, lane = tid & 63, wave = __builtin_amdgcn_readfirstlane(tid >> 6);
    const int G = gridDim.x, bx = blockIdx.x;
    const int gw = bx * NWAVES + wave, NGW = G * NWAVES;
    { CArgs& a = *args_ptr();
      convert_weights(a, lds, gw, NGW, wave, lane);
      norm_rows<false, false>(a.in[I_X], nullptr, 0.f, nullptr, a.in[I_F1N], (bf16*)(a.ws + WS_XN), nullptr, nullptr, gw, NGW, lane); }
    grid.sync();
    GRID_BAR();
    constexpr int NPH = 11;
#pragma nounroll
    for (int ph = 0; ph < DEPTH * NPH; ++ph) {
        const int layer = ph / NPH, p = ph - layer * NPH;
        CArgs& a = *args_ptr();
        bf16* h = (bf16*)a.out; bf16* xn = (bf16*)(a.ws + WS_XN); bf16* mix = xn; bf16* zb = (bf16*)(a.ws + WS_Z); bf16* act = zb;
        const bf16* wl = (const bf16*)(a.ws + WS_W + (size_t)layer * W_LAYER);
        if (p == 0 || p == 8) {
            run_gemm<pg8::EpiSwiGLU, 1>(lds, xn, wl + (p == 0 ? OFF_GU1 : OFF_GU2) / 2, 2 * FF, D, G, bx, pg8::EpiSwiGLU{act, FF});
        } else if (p == 1 || p == 9 || p == 3 || p == 6) {
            const bool dn = (p == 1 || p == 9);
            const bf16* A = dn ? act : xn; const size_t wo = (p == 1) ? OFF_D1 : (p == 9) ? OFF_D2 : (p == 3) ? OFF_IN : OFF_OUT;
            const int N = (p == 3) ? DIN : D, K = dn ? FF : D; bf16* O = dn ? xn : zb;
            run_gemm<pg8::EpiStoreBf16, 4>(lds, A, wl + wo / 2, N, K, G, bx, pg8::EpiStoreBf16{O, N});
        } else if (p == 4) {
            float* HS = (float*)(a.ws + WS_HS); float* HD = (float*)(a.ws + WS_HD);
            for (int it = bx; it < 256; it += G) if ((it & 7) != 7) hgrn_seg<false>(a, lds, layer, it, zb, mix, HS, HD);
            for (int it = bx; it < 256; it += G) lru_pass1(a, lds, layer, it, zb, (float*)(a.ws + WS_LH), (float*)(a.ws + WS_LP), (float*)(a.ws + WS_LE));
            sgu_items(a, lds, layer, bx, G, zb, mix);
        } else if (p == 5) {
            float* HS = (float*)(a.ws + WS_HS); float* HD = (float*)(a.ws + WS_HD);
            for (int it = bx; it < 256; it += G) hgrn_seg<true>(a, lds, layer, it, zb, mix, HS, HD);
            for (int it = bx; it < 256; it += G) lru_pass2(a, lds, layer, it, zb, mix, (const float*)(a.ws + WS_LH), (const float*)(a.ws + WS_LP), (const float*)(a.ws + WS_LE));
        } else {
            const bf16* y = (p == 7) ? zb : xn; const float ys = (p == 7) ? 1.0f : 0.5f; const int lane = opaque_tid() & 63;
            if (p == 10 && layer == DEPTH - 1) norm_rows<true, true>(h, y, ys, nullptr, a.in[I_FN], nullptr, a.out, (float*)(a.ws + WS_Z), gw, NGW, lane);
            else { const float* gain = (p == 2) ? a.in[I_MIXN] + layer * D : (p == 7) ? a.in[I_F2N] + layer * D : a.in[I_F1N] + (layer + 1) * D;
                if (ph == 2) norm_rows<false, false>(a.in[I_X], y, ys, h, gain, xn, nullptr, nullptr, gw, NGW, lane);
                else norm_rows<true, false>(h, y, ys, h, gain, xn, nullptr, nullptr, gw, NGW, lane); }
        }
        GRID_BAR();
    }
    { CArgs& a = *args_ptr(); copy_rows((const float*)(a.ws + WS_Z), a.out, gw, NGW, opaque_tid() & 63); }
}

extern "C" void kernel_launch(void* const* d_in, const int* in_sizes, int n_in, void* d_out, int out_size, void* d_ws, size_t ws_size, hipStream_t stream) {
    static int grid = 0;
    if (grid == 0) {
        if (n_in != 26 || in_sizes[0] != T * D || out_size != T * D || ws_size < WS_END) {
            fprintf(stderr, "kernel_launch: unexpected shapes: n_in %d in0 %d out %d ws %zu (need %zu)\n", n_in, n_in > 0 ? in_sizes[0] : -1, out_size, ws_size, (size_t)WS_END); grid = -1; return; }
        int dev = 0, cus = 0, per_cu = 0;
        (void)hipGetDevice(&dev); (void)hipDeviceGetAttribute(&cus, hipDeviceAttributeMultiprocessorCount, dev);
        if (hipFuncSetAttribute((const void*)fwd_kernel, hipFuncAttributeMaxDynamicSharedMemorySize, LDS_BYTES) != hipSuccess) { fprintf(stderr, "kernel_launch: hipFuncSetAttribute failed\n"); grid = -1; return; }
        if (hipOccupancyMaxActiveBlocksPerMultiprocessor(&per_cu, (const void*)fwd_kernel, NTHREADS, LDS_BYTES) != hipSuccess || per_cu < 1) { fprintf(stderr, "kernel_launch: occupancy query gave %d\n", per_cu); per_cu = 1; }
        (void)hipGetLastError();
        grid = cus * per_cu;
        if (grid < 128) { fprintf(stderr, "kernel_launch: grid %d too small\n", grid); grid = -1; return; }
    }
    if (grid < 0) return;
    if (hipMemsetAsync(d_ws, 0, 65536, stream) != hipSuccess) { fprintf(stderr, "kernel_launch: memset failed\n"); return; }
    Args a{};
    for (int i = 0; i < 26; ++i) a.in[i] = (const float*)d_in[i];
    a.out = (float*)d_out; a.ws = (unsigned char*)d_ws;
    void* args[] = {&a};
    hipError_t e = hipLaunchCooperativeKernel((const void*)fwd_kernel, dim3(grid), dim3(NTHREADS), args, LDS_BYTES, stream);
    if (e != hipSuccess) fprintf(stderr, "kernel_launch: cooperative launch failed: %s (grid %d)\n", hipGetErrorString(e), grid);
}
```

```cpp
#include <hip/hip_runtime.h>
#include <hip/hip_cooperative_groups.h>
#include <cstdio>
#include <cstdint>
namespace cg = cooperative_groups;
namespace pg8 {
#define PG8_LAS __attribute__((address_space(3)))
typedef unsigned short bf16_t;
typedef short bf16x8 __attribute__((ext_vector_type(8)));
typedef float f32x4 __attribute__((ext_vector_type(4)));
typedef unsigned u32x4 __attribute__((ext_vector_type(4)));
constexpr int BM = 256, BK = 64, HALF = 128, HTB = HALF * BK * 2  , STAGE_BYTES = 8 * HTB, NXCD = 8, WGM = 8;

__host__ __device__ __forceinline__ int lds_byte(int r, int c) { const int st = (r >> 4) * 2 + (c >> 5), rr = r & 15, cc = c & 31, ob = rr * 64 + cc * 2; return st * 1024 + (ob ^ (((ob >> 9) & 1) << 5)); }
__host__ __device__ __forceinline__ void stage_rc(int b, int& R, int& C) { const int st = b / 1024, sb = b % 1024, swz = sb ^ (((sb >> 9) & 1) << 5); R = (st >> 1) * 16 + swz / 64; C = (st & 1) * 32 + (swz % 64) / 2; }
__host__ __device__ __forceinline__ int perm32(int rho) { const int n = rho >> 4, i = rho & 15; return 8 * (i >> 2) + 4 * n + (i & 3); }

struct Unit { int pm, pn; };
struct Gemm { const bf16_t* A; const bf16_t* Bt; int M, N, K; };

struct StaticOrder {
    int nM, nN, nwg, G, c;
    __host__ __device__ void init(int M, int N, int G_, int c_) { nM = M / BM; nN = N / BM; nwg = nM * nN; G = G_; c = c_; }
    __host__ __device__ bool next(int i, Unit& u) const {
        const long L = (long)i * G + c; if (L >= nwg) return false;
        int wgid = (int)L; { const int q = nwg / NXCD, r = nwg % NXCD, xcd = wgid % NXCD, off = wgid / NXCD; wgid = (xcd < r ? xcd * (q + 1) : r * (q + 1) + (xcd - r) * q) + off; }
        const int nig = WGM * nN, gid = wgid / nig, fm = gid * WGM, gsz = (nM - fm) < WGM ? (nM - fm) : WGM;
        u.pm = fm + ((wgid % nig) % gsz); u.pn = (wgid % nig) / gsz; return true;
    }
    __device__ __forceinline__ void a_ready(const Unit&) const {}
    __device__ __forceinline__ void done(const Unit&) const {}
};

typedef __bf16 bf16x2_t __attribute__((ext_vector_type(2)));
typedef float f32x2_t __attribute__((ext_vector_type(2)));
__device__ __forceinline__ unsigned cvt_pk_bf16(float lo, float hi) { f32x2_t v = {lo, hi}; bf16x2_t b = __builtin_convertvector(v, bf16x2_t); return __builtin_bit_cast(unsigned, b); }
__device__ __forceinline__ float fsigmoid(float x) { return __builtin_amdgcn_rcpf(1.0f + __expf(-x)); }
struct EpiSwiGLU {
    static constexpr bool PERM = true, AFTER_DRAIN = false;
    bf16_t* O; int ldc;
    __device__ __forceinline__ void operator()(const f32x4 (&acc)[2][2][4][2], const Unit& u, int wr, int wc, int fr, int fq) const {
        const int row0 = u.pm * BM + wr * 64 + fr, col0 = u.pn * HALF + wc * 32 + 8 * fq;
#pragma unroll
        for (int ai = 0; ai < 2; ++ai)
#pragma unroll
            for (int m = 0; m < 4; ++m) { bf16_t* rowp = O + (size_t)(row0 + ai * HALF + m * 16) * ldc + col0;
                float v[8];
#pragma unroll
                for (int n = 0; n < 2; ++n)
#pragma unroll
                    for (int j = 0; j < 4; ++j) { const float g = acc[ai][0][m][n][j], up = acc[ai][1][m][n][j]; v[n * 4 + j] = g * fsigmoid(g) * up; }
                u32x4 w; w.x = cvt_pk_bf16(v[0], v[1]); w.y = cvt_pk_bf16(v[2], v[3]); w.z = cvt_pk_bf16(v[4], v[5]); w.w = cvt_pk_bf16(v[6], v[7]);
                *(u32x4*)rowp = w; }
    }
};
struct EpiStoreBf16 {
    static constexpr bool PERM = true, AFTER_DRAIN = false;
    bf16_t* O; int ldc;
    __device__ __forceinline__ void operator()(const f32x4 (&acc)[2][2][4][2], const Unit& u, int wr, int wc, int fr, int fq) const {
        const int row0 = u.pm * BM + wr * 64 + fr, col0 = u.pn * BM + wc * 32 + 8 * fq;
#pragma unroll
        for (int ai = 0; ai < 2; ++ai)
#pragma unroll
            for (int m = 0; m < 4; ++m) { bf16_t* rowp = O + (size_t)(row0 + ai * HALF + m * 16) * ldc + col0;
#pragma unroll
                for (int bj = 0; bj < 2; ++bj) { const f32x4 v0 = acc[ai][bj][m][0], v1 = acc[ai][bj][m][1];
                    u32x4 w; w.x = cvt_pk_bf16(v0[0], v0[1]); w.y = cvt_pk_bf16(v0[2], v0[3]); w.z = cvt_pk_bf16(v1[0], v1[1]); w.w = cvt_pk_bf16(v1[2], v1[3]);
                    *(u32x4*)(rowp + bj * HALF) = w; } }
    }
};
struct EpiResidual {
    static constexpr bool PERM = false, AFTER_DRAIN = false;
    float* H; int ldc; float scale;
    __device__ __forceinline__ void operator()(const f32x4 (&acc)[2][2][4][2], const Unit& u, int wr, int wc, int fr, int fq) const {
        const int col0 = u.pn * BM + wc * 32 + 4 * fq;
#pragma unroll
        for (int ai = 0; ai < 2; ++ai)
#pragma unroll
            for (int m = 0; m < 4; ++m) { float* rowp = H + (size_t)(u.pm * BM + ai * HALF + wr * 64 + m * 16 + fr) * ldc + col0;
#pragma unroll
                for (int bj = 0; bj < 2; ++bj)
#pragma unroll
                    for (int n = 0; n < 2; ++n) { f32x4* p = (f32x4*)(rowp + bj * HALF + n * 16); const f32x4 o = *p + acc[ai][bj][m][n] * scale; *p = o; }
                asm volatile("" ::: "memory"); }
    }
};
template <class Epi, class Sched, bool ALIGN_EPI = false, bool SP2 = false>
__device__ __forceinline__ void gemm_phase(PG8_LAS unsigned char* lds, const Gemm g, const Sched& S, const Epi& E) {
    const int tid = threadIdx.x, wid = __builtin_amdgcn_readfirstlane(tid >> 6), lane = tid & 63, wr = wid >> 2, wc = wid & 3, fr = lane & 15, fq = lane >> 4;
    const int K = g.K, nt = K / BK;
    unsigned voffA[2], voffB[2];
#pragma unroll
    for (int i = 0; i < 2; ++i) { int R, C; stage_rc(tid * 16 + i * 8192, R, C); const int Rb = Epi::PERM ? ((R & ~31) + perm32(R & 31)) : R;
        voffA[i] = (unsigned)(R * K + C) * 2u; voffB[i] = (unsigned)(Rb * K + C) * 2u; }
    const size_t kstep = (size_t)(BK * 2);
    const size_t hstep = (size_t)HALF * K * 2;
    const size_t tstep = 2 * hstep;
    const unsigned ldsw = (unsigned)wid * 1024u;
    const int aoff = lds_byte(wr * 64 + fr, fq * 8), boff = lds_byte(wc * 32 + fr, fq * 8);
#define PG8_SA(b, h) (((b) * 2 + (h)) * HTB)
#define PG8_SB(b, h) ((4 + (b) * 2 + (h)) * HTB)
#define PG8_STAGE(bufoff, gbase, voff) do { _Pragma("unroll") for (int _i = 0; _i < 2; ++_i) \
        __builtin_amdgcn_global_load_lds((const unsigned*)((const char*)(gbase) + (voff)[_i]), (PG8_LAS unsigned*)(lds + (bufoff) + ldsw + _i * 8192), 16, 0, 0); } while (0)
#define PG8_LDA(dst, b, h) do { _Pragma("unroll") for (int m = 0; m < 4; ++m) _Pragma("unroll") for (int k = 0; k < 2; ++k) dst[m][k] = *(const PG8_LAS bf16x8*)(lds + PG8_SA(b, h) + aoff + m * 2048 + k * 1024); } while (0)
#define PG8_LDB(dst, b, h) do { _Pragma("unroll") for (int n = 0; n < 2; ++n) _Pragma("unroll") for (int k = 0; k < 2; ++k) dst[n][k] = *(const PG8_LAS bf16x8*)(lds + PG8_SB(b, h) + boff + n * 2048 + k * 1024); } while (0)
#define PG8_MMA(ai, bj, At, Bt) do { __builtin_amdgcn_s_setprio(1); _Pragma("unroll") for (int m = 0; m < 4; ++m) _Pragma("unroll") for (int n = 0; n < 2; ++n) _Pragma("unroll") for (int k = 0; k < 2; ++k) \
        acc[ai][bj][m][n] = __builtin_amdgcn_mfma_f32_16x16x32_bf16(Bt[n][k], At[m][k], acc[ai][bj][m][n], 0, 0, 0); __builtin_amdgcn_s_setprio(0); } while (0)
#define PG8_WAIT_V(n) asm volatile("s_waitcnt vmcnt(" #n ")" ::: "memory")
#define PG8_WAIT_L(n) asm volatile("s_waitcnt lgkmcnt(" #n ")" ::: "memory")
#define PG8_BAR __builtin_amdgcn_s_barrier()
#define PG8_SCHED __builtin_amdgcn_sched_barrier(0)
    Unit cur, nxt; int ui = 0;
    if (!S.next(0, cur)) return;
    f32x4 acc[2][2][4][2];
#pragma unroll
    for (int a = 0; a < 2; ++a)
#pragma unroll
        for (int b = 0; b < 2; ++b)
#pragma unroll
            for (int m = 0; m < 4; ++m)
#pragma unroll
                for (int n = 0; n < 2; ++n) acc[a][b][m][n] = (f32x4){0.f, 0.f, 0.f, 0.f};
    bf16x8 At[4][2], B0[2][2], B1[2][2];
    const char* cA = (const char*)g.A + (size_t)cur.pm * tstep; const char* cB = (const char*)g.Bt + (size_t)cur.pn * tstep;
    S.a_ready(cur);
    if constexpr (SP2) {
        PG8_STAGE(PG8_SB(0, 0), cB, voffB); PG8_STAGE(PG8_SB(0, 1), cB + hstep, voffB); PG8_STAGE(PG8_SA(0, 0), cA, voffA); PG8_STAGE(PG8_SA(0, 1), cA + hstep, voffA);
        if (wr == 1) PG8_BAR;
        PG8_WAIT_V(2); PG8_BAR;
        PG8_STAGE(PG8_SB(1, 0), cB + kstep, voffB); PG8_STAGE(PG8_SA(1, 0), cA + kstep, voffA); PG8_STAGE(PG8_SB(1, 1), cB + hstep + kstep, voffB);
        PG8_WAIT_V(6); PG8_BAR;
    } else {
        PG8_STAGE(PG8_SB(0, 0), cB, voffB); PG8_STAGE(PG8_SA(0, 0), cA, voffA); PG8_STAGE(PG8_SB(0, 1), cB + hstep, voffB); PG8_STAGE(PG8_SA(0, 1), cA + hstep, voffA);
        if (wr == 1) PG8_BAR;
        PG8_WAIT_V(4); PG8_BAR;
        PG8_STAGE(PG8_SB(1, 0), cB + kstep, voffB); PG8_STAGE(PG8_SA(1, 0), cA + kstep, voffA); PG8_STAGE(PG8_SB(1, 1), cB + hstep + kstep, voffB);
        PG8_WAIT_V(6); PG8_BAR;
    }
    for (;;) {
        const bool has_next = S.next(ui + 1, nxt);
        const char* nA = has_next ? (const char*)g.A + (size_t)nxt.pm * tstep : cA; const char* nB = has_next ? (const char*)g.Bt + (size_t)nxt.pn * tstep : cB;
        for (int t = 0; t < nt; t += 2) {
            const bool last = (t == nt - 2);
            const char* a1 = cA + (size_t)(t + 1) * kstep;
            const char* a2 = last ? nA : cA + (size_t)(t + 2) * kstep; const char* b2 = last ? nB : cB + (size_t)(t + 2) * kstep;
            const char* a3 = a2 + kstep; const char* b3 = b2 + kstep;
            if (last && has_next) S.a_ready(nxt);
            if constexpr (SP2) {
            PG8_LDB(B0, 0, 0); PG8_LDB(B1, 0, 1); PG8_SCHED; PG8_LDA(At, 0, 0); PG8_STAGE(PG8_SA(1, 1), a1 + hstep, voffA);
            PG8_WAIT_V(8); PG8_WAIT_L(0); PG8_BAR; PG8_MMA(0, 0, At, B0); PG8_MMA(0, 1, At, B1); PG8_BAR; PG8_SCHED;
            PG8_LDA(At, 0, 1); PG8_STAGE(PG8_SB(0, 0), b2, voffB); PG8_STAGE(PG8_SB(0, 1), b2 + hstep, voffB); PG8_STAGE(PG8_SA(0, 0), a2, voffA);
            PG8_WAIT_V(8); PG8_WAIT_L(0); PG8_BAR; PG8_MMA(1, 0, At, B0); PG8_MMA(1, 1, At, B1); PG8_BAR; PG8_SCHED;
            PG8_LDB(B0, 1, 0); PG8_LDB(B1, 1, 1); PG8_SCHED; PG8_LDA(At, 1, 0); PG8_STAGE(PG8_SA(0, 1), a2 + hstep, voffA);
            PG8_WAIT_V(8); PG8_WAIT_L(0); PG8_BAR; PG8_MMA(0, 0, At, B0); PG8_MMA(0, 1, At, B1); PG8_BAR; PG8_SCHED;
            PG8_LDA(At, 1, 1); PG8_STAGE(PG8_SB(1, 0), b3, voffB); PG8_STAGE(PG8_SB(1, 1), b3 + hstep, voffB); PG8_STAGE(PG8_SA(1, 0), a3, voffA);
            PG8_WAIT_V(8); PG8_WAIT_L(0); PG8_BAR; PG8_MMA(1, 0, At, B0); PG8_MMA(1, 1, At, B1); PG8_BAR; PG8_SCHED;
            } else {
            PG8_LDB(B0, 0, 0); PG8_SCHED; PG8_LDA(At, 0, 0); PG8_STAGE(PG8_SA(1, 1), a1 + hstep, voffA);
            PG8_WAIT_L(8); PG8_BAR; PG8_WAIT_L(0); PG8_MMA(0, 0, At, B0); PG8_BAR; PG8_SCHED;
            PG8_LDB(B1, 0, 1); PG8_STAGE(PG8_SB(0, 0), b2, voffB);
            PG8_BAR; PG8_WAIT_L(0); PG8_MMA(0, 1, At, B1); PG8_BAR;
            PG8_LDA(At, 0, 1); PG8_STAGE(PG8_SA(0, 0), a2, voffA);
            PG8_BAR; PG8_WAIT_L(0); PG8_MMA(1, 0, At, B0); PG8_BAR; PG8_SCHED;
            PG8_STAGE(PG8_SB(0, 1), b2 + hstep, voffB);
            PG8_WAIT_V(6); PG8_BAR; PG8_MMA(1, 1, At, B1); PG8_BAR;
            PG8_LDB(B0, 1, 0); PG8_SCHED; PG8_LDA(At, 1, 0); PG8_STAGE(PG8_SA(0, 1), a2 + hstep, voffA);
            PG8_WAIT_L(8); PG8_BAR; PG8_WAIT_L(0); PG8_MMA(0, 0, At, B0); PG8_BAR; PG8_SCHED;
            PG8_LDB(B1, 1, 1); PG8_STAGE(PG8_SB(1, 0), b3, voffB);
            PG8_BAR; PG8_WAIT_L(0); PG8_MMA(0, 1, At, B1); PG8_BAR;
            PG8_LDA(At, 1, 1); PG8_STAGE(PG8_SA(1, 0), a3, voffA);
            PG8_BAR; PG8_WAIT_L(0); PG8_MMA(1, 0, At, B0); PG8_BAR; PG8_SCHED;
            PG8_STAGE(PG8_SB(1, 1), b3 + hstep, voffB);
            PG8_WAIT_V(6); PG8_BAR; PG8_MMA(1, 1, At, B1); PG8_BAR;
            }
        }
        if constexpr (ALIGN_EPI) { if (wr == 0) PG8_BAR; }
        if constexpr (!Epi::AFTER_DRAIN) { E(acc, cur, wr, wc, fr, fq); S.done(cur); }
        if (!has_next) break;
#pragma unroll
        for (int a = 0; a < 2; ++a)
#pragma unroll
            for (int b = 0; b < 2; ++b)
#pragma unroll
                for (int m = 0; m < 4; ++m)
#pragma unroll
                    for (int n = 0; n < 2; ++n) acc[a][b][m][n] = (f32x4){0.f, 0.f, 0.f, 0.f};
        cur = nxt; cA = nA; cB = nB; ++ui;
        if constexpr (ALIGN_EPI) { if (wr == 1) PG8_BAR; }
    }
    PG8_WAIT_V(0);
    if constexpr (!ALIGN_EPI) { if (wr == 0) PG8_BAR; }
    PG8_BAR;
    if constexpr (Epi::AFTER_DRAIN) { E.fused(acc, cur, wr, wc, fr, fq, lds, wid, lane); S.done(cur); }
#undef PG8_SA
#undef PG8_SB
#undef PG8_STAGE
#undef PG8_LDA
#undef PG8_LDB
#undef PG8_MMA
#undef PG8_WAIT_V
#undef PG8_WAIT_L
#undef PG8_BAR
#undef PG8_SCHED
}
}

#define LAS __attribute__((address_space(3)))
typedef unsigned short bf16;
typedef short bf16x8 __attribute__((ext_vector_type(8)));
typedef float f32x4 __attribute__((ext_vector_type(4)));
typedef unsigned u32x4 __attribute__((ext_vector_type(4)));
typedef unsigned u32x2 __attribute__((ext_vector_type(2)));
using pg8::cvt_pk_bf16;
using pg8::fsigmoid;

#ifndef HG_SCALE
#define HG_SCALE 1.0f
#endif
#ifndef LR_SCALE
#define LR_SCALE 1.0f
#endif
#ifndef SG_SCALE
#define SG_SCALE 1.0f
#endif
#ifndef GEMM_MASK
#define GEMM_MASK 0
#endif
constexpr int NWAVES = 8, NTHREADS = 512;
constexpr int DEPTH = 4, BATCH = 8, SEQ = 4096, D = 1024, T = BATCH * SEQ, FF = 2816, DIN = 3072;
constexpr float EPS = 1e-6f;
constexpr int LDS_BYTES = 147456;
constexpr int ZQ = 0, ZF = 512, ZI = 1024, ZG = 1536, ZX = 2048, ZGATE = 2304, ZU = 2560, ZV = 2816;
constexpr size_t MiB = 1u << 20;
constexpr size_t W_GU = (size_t)2 * FF * D * 2, W_D = (size_t)D * FF * 2, W_IN = (size_t)DIN * D * 2, W_OUT = (size_t)D * D * 2;
constexpr size_t OFF_GU1 = 0, OFF_D1 = OFF_GU1 + W_GU, OFF_IN = OFF_D1 + W_D, OFF_OUT = OFF_IN + W_IN, OFF_GU2 = OFF_OUT + W_OUT, OFF_D2 = OFF_GU2 + W_GU, W_LAYER = OFF_D2 + W_D;
constexpr size_t WS_W = 1 * MiB, WS_XN = WS_W + DEPTH * W_LAYER, WS_Z = WS_XN + (size_t)T * D * 2, WS_HS = WS_Z + (size_t)T * DIN * 2, WS_HD = WS_HS + (size_t)256 * 65536, WS_LE = WS_HD + 256 * 512, WS_LH = WS_LE + 256 * 512, WS_LP = WS_LH + (size_t)T * 256 * 4, WS_END = WS_LP + (size_t)T * 256 * 4;

struct Args { const float* in[26]; float* out; unsigned char* ws; };
typedef const Args __attribute__((address_space(4))) CArgs;
enum { I_X = 0, I_F1N, I_F1G, I_F1U, I_F1D, I_MIXN, I_WIN, I_LB, I_HN, I_CW, I_CB, I_WA, I_BA, I_WX, I_BX, I_LAM, I_LN, I_SW, I_SB, I_SN, I_WOUT, I_F2N, I_F2G, I_F2U, I_F2D, I_FN };

__device__ __forceinline__ float bf2f(unsigned short h) { return __uint_as_float((unsigned)h << 16); }
__device__ __forceinline__ unsigned short f2bf(float f) { return (unsigned short)(cvt_pk_bf16(f, 0.f) & 0xffffu); }
__device__ __forceinline__ float gelu_t(float x) { return x * fsigmoid(1.5957691216f * (x + 0.044715f * x * x * x)); }
__device__ __forceinline__ float silu_f(float x) { return x * fsigmoid(x); }
__device__ __forceinline__ float wave_sum(float v) {
#pragma unroll
    for (int o = 1; o < 64; o <<= 1) v += __shfl_xor(v, o);
    return v;
}
#define BLOCK_SYNC() do { asm volatile("s_waitcnt lgkmcnt(0)" ::: "memory"); __builtin_amdgcn_s_barrier(); asm volatile("" ::: "memory"); } while (0)
__device__ __forceinline__ int opaque_tid() { int t = threadIdx.x; asm volatile("" : "+v"(t)); return t; }

__device__ __forceinline__ void transpose_item(const float* W, int K, int N, bf16* WT, int k0, int n0, int drow0, LAS float* scr, int lane) {
#pragma unroll 8
    for (int i = 0; i < 32; ++i) { const int kk = 2 * i + (lane >> 5); scr[kk * 33 + (lane & 31)] = W[(size_t)(k0 + kk) * N + n0 + (lane & 31)]; }
    asm volatile("s_waitcnt lgkmcnt(0)" ::: "memory");
    const int c = lane & 7;
#pragma unroll
    for (int j = 0; j < 4; ++j) { const int n = (lane >> 3) + 8 * j; const LAS float* s = scr + (8 * c) * 33 + n;
        u32x4 o; o.x = cvt_pk_bf16(s[0 * 33], s[1 * 33]); o.y = cvt_pk_bf16(s[2 * 33], s[3 * 33]); o.z = cvt_pk_bf16(s[4 * 33], s[5 * 33]); o.w = cvt_pk_bf16(s[6 * 33], s[7 * 33]);
        *(u32x4*)(WT + (size_t)(drow0 + n) * K + k0 + 8 * c) = o; }
    asm volatile("s_waitcnt lgkmcnt(0)" ::: "memory");
}
__device__ __forceinline__ void convert_weights(CArgs& a, LAS unsigned char* lds, int gw, int NGW, int wave, int lane) {
    LAS float* scr = (LAS float*)(lds + wave * 16384);
    constexpr int I_FFU = (D / 64) * (FF / 32), I_FFD = (FF / 64) * (D / 32), I_IN_ = (D / 64) * (DIN / 32), I_OUT_ = (D / 64) * (D / 32);
    constexpr int PER_LAYER = 4 * I_FFU + 2 * I_FFD + I_IN_ + I_OUT_;
    for (int it = gw; it < DEPTH * PER_LAYER; it += NGW) {
        const int layer = it / PER_LAYER; int r = it % PER_LAYER;
        bf16* wl = (bf16*)(a.ws + WS_W + (size_t)layer * W_LAYER);
        const float* src; int K, N; bf16* dst; int mode = 0;
        if (r < I_FFU) { src = a.in[I_F1G] + (size_t)layer * D * FF; K = D; N = FF; dst = wl + OFF_GU1 / 2; mode = 1; }
        else if ((r -= I_FFU) < I_FFU) { src = a.in[I_F1U] + (size_t)layer * D * FF; K = D; N = FF; dst = wl + OFF_GU1 / 2; mode = 2; }
        else if ((r -= I_FFU) < I_FFD) { src = a.in[I_F1D] + (size_t)layer * D * FF; K = FF; N = D; dst = wl + OFF_D1 / 2; }
        else if ((r -= I_FFD) < I_IN_) { src = a.in[I_WIN] + (size_t)layer * D * DIN; K = D; N = DIN; dst = wl + OFF_IN / 2; }
        else if ((r -= I_IN_) < I_OUT_) { src = a.in[I_WOUT] + (size_t)layer * D * D; K = D; N = D; dst = wl + OFF_OUT / 2; }
        else if ((r -= I_OUT_) < I_FFU) { src = a.in[I_F2G] + (size_t)layer * D * FF; K = D; N = FF; dst = wl + OFF_GU2 / 2; mode = 1; }
        else if ((r -= I_FFU) < I_FFU) { src = a.in[I_F2U] + (size_t)layer * D * FF; K = D; N = FF; dst = wl + OFF_GU2 / 2; mode = 2; }
        else { r -= I_FFU; src = a.in[I_F2D] + (size_t)layer * D * FF; K = FF; N = D; dst = wl + OFF_D2 / 2; }
        const int nblk = N / 32, kb = r / nblk, nb = r % nblk, n0 = 32 * nb;
        const int drow0 = mode == 0 ? n0 : ((n0 >> 7) * 256 + (n0 & 127) + (mode == 2 ? 128 : 0));
        transpose_item(src, K, N, dst, 64 * kb, n0, drow0, scr, lane);
    }
}
template <bool HB, bool FINAL>
__device__ __forceinline__ void norm_rows(const void* src, const bf16* y, float ys, bf16* hdst, const float* gain, bf16* xn, float* fout, float* fstage, int gw, int NGW, int lane) {
    f32x4 gv[4];
#pragma unroll
    for (int j = 0; j < 4; ++j) gv[j] = ((const f32x4*)gain)[lane + 64 * j];
    for (int m0 = gw; m0 < T; m0 += 2 * NGW) {
        f32x4 v[2][4]; u32x2 yw[2][4];
#pragma unroll
        for (int r = 0; r < 2; ++r) { const int m = m0 + r * NGW;
            if (HB) { const u32x2* hr = (const u32x2*)((const bf16*)src + (size_t)m * D) + lane;
#pragma unroll
                for (int j = 0; j < 4; ++j) { const u32x2 w = hr[64 * j]; v[r][j] = (f32x4){__uint_as_float(w.x << 16), __uint_as_float(w.x & 0xffff0000u), __uint_as_float(w.y << 16), __uint_as_float(w.y & 0xffff0000u)}; }
            } else { const f32x4* xr = (const f32x4*)((const float*)src + (size_t)m * D) + lane;
#pragma unroll
                for (int j = 0; j < 4; ++j) v[r][j] = xr[64 * j]; }
            if (y) { const u32x2* yr = (const u32x2*)(y + (size_t)m * D) + lane;
#pragma unroll
                for (int j = 0; j < 4; ++j) yw[r][j] = yr[64 * j]; } }
        float s[2];
#pragma unroll
        for (int r = 0; r < 2; ++r) { s[r] = 0.f;
            if (y) {
#pragma unroll
                for (int j = 0; j < 4; ++j) { const u32x2 w = yw[r][j];
                    v[r][j].x += ys * __uint_as_float(w.x << 16); v[r][j].y += ys * __uint_as_float(w.x & 0xffff0000u); v[r][j].z += ys * __uint_as_float(w.y << 16); v[r][j].w += ys * __uint_as_float(w.y & 0xffff0000u); } }
#pragma unroll
            for (int j = 0; j < 4; ++j) s[r] += (v[r][j].x * v[r][j].x + v[r][j].y * v[r][j].y) + (v[r][j].z * v[r][j].z + v[r][j].w * v[r][j].w); }
#pragma unroll
        for (int o = 1; o < 64; o <<= 1) { s[0] += __shfl_xor(s[0], o); s[1] += __shfl_xor(s[1], o); }
#pragma unroll
        for (int r = 0; r < 2; ++r) { const int m = m0 + r * NGW; const float rstd = rsqrtf(s[r] * (1.f / D) + EPS);
            if (!FINAL && hdst) { u32x2* hr = (u32x2*)(hdst + (size_t)m * D) + lane;
#pragma unroll
                for (int j = 0; j < 4; ++j) { u32x2 w; w.x = cvt_pk_bf16(v[r][j].x, v[r][j].y); w.y = cvt_pk_bf16(v[r][j].z, v[r][j].w); hr[64 * j] = w; } }
            if (FINAL) { f32x4* o = (f32x4*)((m >= T / 2 ? fout : fstage) + (size_t)m * D) + lane;
#pragma unroll
                for (int j = 0; j < 4; ++j) o[64 * j] = v[r][j] * rstd * gv[j];
            } else { u32x2* o = (u32x2*)(xn + (size_t)m * D) + lane;
#pragma unroll
                for (int j = 0; j < 4; ++j) { const f32x4 q = v[r][j] * rstd * gv[j]; u32x2 w; w.x = cvt_pk_bf16(q.x, q.y); w.y = cvt_pk_bf16(q.z, q.w); o[64 * j] = w; } } }
    }
}
__device__ __forceinline__ void copy_rows(const float* st, float* out, int gw, int NGW, int lane) {
    for (int m = gw; m < T / 2; m += NGW) { const f32x4* a = (const f32x4*)(st + (size_t)m * D) + lane; f32x4* o = (f32x4*)(out + (size_t)m * D) + lane;
        f32x4 v[4];
#pragma unroll
        for (int j = 0; j < 4; ++j) v[j] = a[64 * j];
#pragma unroll
        for (int j = 0; j < 4; ++j) o[64 * j] = v[j]; }
}

template <int KSTEPS>
__device__ __forceinline__ f32x4 mma16(const LAS bf16* A, int lda, const LAS bf16* B, int ldb, f32x4 acc, int fr, int fq) {
    const LAS bf16* ap = A + fr * lda + fq * 8; const LAS bf16* bp = B + fr * ldb + fq * 8;
#pragma unroll
    for (int kk = 0; kk < KSTEPS; ++kk) {
        const bf16x8 av = *(const LAS bf16x8*)(ap + kk * 32); const bf16x8 bv = *(const LAS bf16x8*)(bp + kk * 32);
        acc = __builtin_amdgcn_mfma_f32_16x16x32_bf16(bv, av, acc, 0, 0, 0);
    }
    return acc;
}

constexpr int QLD = 136, SLD = 72;
constexpr int NSEG = 8, SEG_CHUNKS = SEQ / 64 / NSEG;
template <bool FULL>
__device__ __forceinline__ void hgrn_seg(CArgs& a, LAS unsigned char* lds, int layer, int item, const bf16* z, bf16* mix, float* HS, float* HD) {
    const int tid = opaque_tid(), lane = tid & 63, wave = tid >> 6, fr = lane & 15, fq = lane >> 4;
    const int b = item >> 5, hd = (item >> 3) & 3, sgi = item & 7;
    LAS bf16* Q = (LAS bf16*)(lds);
    LAS bf16* Kt = (LAS bf16*)(lds + 17408);
    LAS bf16* KsT = (LAS bf16*)(lds + 34816);
    LAS bf16* VT = (LAS bf16*)(lds + 53248);
    LAS bf16* S = (LAS bf16*)(lds + 71680);
    LAS bf16* StT = (LAS bf16*)(lds + 80896);
    LAS float* dk = (LAS float*)(lds + 115712);
    LAS float* seg = (LAS float*)(lds + 116224);
    LAS float* red = (LAS float*)(lds + 118272);
    const int ch = tid & 127, tq = tid >> 7;
    float lb;
    { const float* lg = a.in[I_LB] + hd * 128 + ch; const float l0 = lg[0], l1 = lg[512], l2 = lg[1024], l3 = lg[1536];
      const float mx = fmaxf(fmaxf(l0, l1), fmaxf(l2, l3)); const float e0 = __expf(l0 - mx), e1 = __expf(l1 - mx), e2 = __expf(l2 - mx), e3 = __expf(l3 - mx);
      const float inv = 1.f / (e0 + e1 + e2 + e3); lb = (layer >= 1 ? e1 : 0.f) + (layer >= 2 ? e2 : 0.f) + (layer >= 3 ? e3 : 0.f); lb *= inv; }
    const float oml = 1.f - lb;
    f32x4 st[8];
#pragma unroll
    for (int i = 0; i < 8; ++i) st[i] = (f32x4){0.f, 0.f, 0.f, 0.f};
    if (FULL) {
        for (int j = 0; j < sgi; ++j) { const float* Sj = HS + (size_t)(item - sgi + j) * 16384 + (16 * wave + fr) * 128 + 4 * fq; const float* Dj = HD + (item - sgi + j) * 128 + 4 * fq;
#pragma unroll
            for (int kb = 0; kb < 8; ++kb) st[kb] = st[kb] * *(const f32x4*)(Dj + 16 * kb) + *(const f32x4*)(Sj + 16 * kb); }
#pragma unroll
        for (int kb = 0; kb < 8; ++kb) { u32x2 w; w.x = cvt_pk_bf16(st[kb][0], st[kb][1]); w.y = cvt_pk_bf16(st[kb][2], st[kb][3]);
            *(LAS u32x2*)(StT + (16 * wave + fr) * QLD + 16 * kb + 4 * fq) = w; }
    }
    const int tb = wave & 3, vh = wave >> 2;
    const float* gn = a.in[I_HN] + layer * 512 + hd * 128;
    float dsum = 1.f;
    f32x4 ggv[4];
    if (FULL) {
#pragma unroll
        for (int i = 0; i < 4; ++i) ggv[i] = *(const f32x4*)(gn + 16 * ((wave >> 2) * 4 + i) + 4 * fq); }
    unsigned short rf[16], rq[16], ri[16];
    const size_t tseg = (size_t)b * SEQ + (size_t)sgi * SEG_CHUNKS * 64;
    { const bf16* zr = z + (tseg + tq * 16) * DIN + hd * 128 + ch;
#pragma unroll
      for (int j = 0; j < 16; ++j) { rf[j] = zr[(size_t)j * DIN + ZF]; ri[j] = zr[(size_t)j * DIN + ZI]; if (FULL) rq[j] = zr[(size_t)j * DIN + ZQ]; } }
    BLOCK_SYNC();
    for (int c = 0; c < SEG_CHUNKS; ++c) {
        const size_t t0 = tseg + c * 64;
        float bl[16], kv[16]; float run = 1.f;
#pragma unroll
        for (int j = 0; j < 16; ++j) { const float x = fminf(fmaxf(bf2f(rf[j]), -30.f), 30.f); const float e = __expf(-x), sg = __builtin_amdgcn_rcpf(1.f + e);
            const float f = lb + oml * sg; run *= f; bl[j] = run; kv[j] = oml * e * sg; }
        seg[tq * 128 + ch] = run;
        BLOCK_SYNC();
        float prefix = 1.f, total = 1.f;
#pragma unroll
        for (int q = 0; q < 4; ++q) { const float sv = seg[q * 128 + ch]; total *= sv; if (q < tq) prefix *= sv; }
        dsum *= total;
        unsigned ksp[8], vip[8];
#pragma unroll
        for (int j = 0; j < 16; j += 2) {
            float ks2[2];
#pragma unroll
            for (int jj = 0; jj < 2; ++jj) { const int t = j + jj; const float e1 = fmaxf(prefix * bl[t], 1e-35f), e2 = __builtin_amdgcn_rcpf(e1);
                if (FULL) { const float qx = bf2f(rq[t]); const float qv = qx * fsigmoid(qx);
                    Q[(tq * 16 + t) * QLD + ch] = f2bf(qv * e1);
                    Kt[(tq * 16 + t) * QLD + ch] = f2bf(kv[t] * e2); }
                ks2[jj] = kv[t] * (total * e2); }
            ksp[j >> 1] = cvt_pk_bf16(ks2[0], ks2[1]); vip[j >> 1] = (unsigned)ri[j] | ((unsigned)ri[j + 1] << 16);
        }
        { LAS u32x4* kp = (LAS u32x4*)(KsT + ch * SLD + tq * 16); kp[0] = (u32x4){ksp[0], ksp[1], ksp[2], ksp[3]}; kp[1] = (u32x4){ksp[4], ksp[5], ksp[6], ksp[7]};
          LAS u32x4* vp = (LAS u32x4*)(VT + ch * SLD + tq * 16); vp[0] = (u32x4){vip[0], vip[1], vip[2], vip[3]}; vp[1] = (u32x4){vip[4], vip[5], vip[6], vip[7]}; }
        if (tq == 0) dk[ch] = total;
        if (c + 1 < SEG_CHUNKS) { const bf16* zr = z + (t0 + 64 + tq * 16) * DIN + hd * 128 + ch;
#pragma unroll
            for (int j = 0; j < 16; ++j) { rf[j] = zr[(size_t)j * DIN + ZF]; ri[j] = zr[(size_t)j * DIN + ZI]; if (FULL) rq[j] = zr[(size_t)j * DIN + ZQ]; } }
        u32x2 gwv[4];
        if (FULL) { const bf16* gr = z + (t0 + 16 * tb + fr) * DIN + ZG + hd * 128;
#pragma unroll
            for (int i = 0; i < 4; ++i) gwv[i] = *(const u32x2*)(gr + 16 * (vh * 4 + i) + 4 * fq); }
        BLOCK_SYNC();
        if (FULL) {
#pragma unroll
        for (int i = 0; i < 2; ++i) { const int sb = vh * 2 + i;
            f32x4 acc = (f32x4){0.f, 0.f, 0.f, 0.f};
            if (sb <= tb) acc = mma16<4>(Q + 16 * tb * QLD, QLD, Kt + 16 * sb * QLD, QLD, acc, fr, fq);
            const int t = 16 * tb + fr, s0 = 16 * sb + 4 * fq;
            u32x2 w; w.x = cvt_pk_bf16(s0 <= t ? acc[0] : 0.f, s0 + 1 <= t ? acc[1] : 0.f); w.y = cvt_pk_bf16(s0 + 2 <= t ? acc[2] : 0.f, s0 + 3 <= t ? acc[3] : 0.f);
            *(LAS u32x2*)(S + t * SLD + s0) = w; }
        BLOCK_SYNC();
        f32x4 o[4]; float ss = 0.f;
#pragma unroll
        for (int i = 0; i < 4; ++i) { const int vb = vh * 4 + i;
            f32x4 acc = (f32x4){0.f, 0.f, 0.f, 0.f};
            acc = mma16<2>(S + 16 * tb * SLD, SLD, VT + 16 * vb * SLD, SLD, acc, fr, fq);
            acc = mma16<4>(Q + 16 * tb * QLD, QLD, StT + 16 * vb * QLD, QLD, acc, fr, fq);
            o[i] = acc; ss += (acc[0] * acc[0] + acc[1] * acc[1]) + (acc[2] * acc[2] + acc[3] * acc[3]); }
        ss += __shfl_xor(ss, 16); ss += __shfl_xor(ss, 32);
        if (fq == 0) red[vh * 64 + 16 * tb + fr] = ss;
        BLOCK_SYNC();
        { const int t = 16 * tb + fr; const float rs = rsqrtf((red[t] + red[64 + t]) * (1.f / 128.f) + EPS);
          bf16* mr = mix + (t0 + t) * D + hd * 128;
#pragma unroll
          for (int i = 0; i < 4; ++i) { const int v0 = 16 * (vh * 4 + i) + 4 * fq;
              const u32x2 gw = gwv[i]; const f32x4 gg = ggv[i];
              const float g0 = __uint_as_float(gw.x << 16), g1 = __uint_as_float(gw.x & 0xffff0000u), g2 = __uint_as_float(gw.y << 16), g3 = __uint_as_float(gw.y & 0xffff0000u);
              u32x2 w; w.x = cvt_pk_bf16(o[i][0] * rs * gg[0] * silu_f(g0), o[i][1] * rs * gg[1] * silu_f(g1));
              w.y = cvt_pk_bf16(o[i][2] * rs * gg[2] * silu_f(g2), o[i][3] * rs * gg[3] * silu_f(g3));
              *(u32x2*)(mr + v0) = w; } }
        }
#pragma unroll
        for (int kb = 0; kb < 8; ++kb) { const f32x4 d4 = *(const LAS f32x4*)(dk + 16 * kb + 4 * fq);
            st[kb] = st[kb] * d4;
            st[kb] = mma16<2>(VT + 16 * wave * SLD, SLD, KsT + 16 * kb * SLD, SLD, st[kb], fr, fq);
            if (FULL) { u32x2 w; w.x = cvt_pk_bf16(st[kb][0], st[kb][1]); w.y = cvt_pk_bf16(st[kb][2], st[kb][3]);
                *(LAS u32x2*)(StT + (16 * wave + fr) * QLD + 16 * kb + 4 * fq) = w; } }
        BLOCK_SYNC();
    }
    if (!FULL) {
        float* So = HS + (size_t)item * 16384 + (16 * wave + fr) * 128 + 4 * fq;
#pragma unroll
        for (int kb = 0; kb < 8; ++kb) *(f32x4*)(So + 16 * kb) = st[kb];
        if (tq == 0) HD[item * 128 + ch] = dsum;
    }
}

__device__ __forceinline__ void lru_pass1(CArgs& a, LAS unsigned char* lds, int layer, int item, const bf16* z, float* LH, float* LP, float* LE) {
    const int tid = opaque_tid(), lane = tid & 63, wave = tid >> 6, fr = lane & 15, fq = lane >> 4;
    const int b = item >> 5, blk = (item >> 3) & 3, sgi = item & 7;
    LAS bf16* WaT = (LAS bf16*)(lds);
    LAS bf16* WxT = (LAS bf16*)(lds + 9216);
    LAS bf16* XC = (LAS bf16*)(lds + 18432);
    LAS float* XCf = (LAS float*)(lds + 27648);
    LAS float* Af = (LAS float*)(lds + 44032);
    LAS float* Uf = (LAS float*)(lds + 60416);
    LAS float* segP = (LAS float*)(lds + 76800);
    LAS float* segH = (LAS float*)(lds + 78848);
    LAS float* carry = (LAS float*)(lds + 80896);
    const int cbase = blk * 64;
    { const float* wa = a.in[I_WA] + ((size_t)layer * 4 + blk) * 4096; const float* wx = a.in[I_WX] + ((size_t)layer * 4 + blk) * 4096;
      for (int e = tid; e < 4096; e += NTHREADS) { const int i = e >> 6, j = e & 63; WaT[j * SLD + i] = f2bf(wa[e]); WxT[j * SLD + i] = f2bf(wx[e]); } }
    if (tid < 64) { carry[tid] = 0.f; carry[64 + tid] = 1.f; }
    const int ct = tid >> 3, c8 = (tid & 7) * 8;
    float cw[4][8], cb[8];
#pragma unroll
    for (int k = 0; k < 8; ++k) { cb[k] = a.in[I_CB][layer * 256 + cbase + c8 + k];
#pragma unroll
        for (int tap = 0; tap < 4; ++tap) cw[tap][k] = a.in[I_CW][(layer * 4 + tap) * 256 + cbase + c8 + k]; }
    const int tb = wave & 3, jh = wave >> 2;
    float gba[2][4], gbx[2][4], gsp[2][4];
#pragma unroll
    for (int i = 0; i < 2; ++i)
#pragma unroll
        for (int j = 0; j < 4; ++j) { const int col = 16 * (jh * 2 + i) + 4 * fq + j;
            gba[i][j] = a.in[I_BA][layer * 256 + cbase + col]; gbx[i][j] = a.in[I_BX][layer * 256 + cbase + col];
            const float lam = a.in[I_LAM][layer * 256 + cbase + col]; gsp[i][j] = log1pf(__expf(-lam)); }
    const int tl0 = sgi * 512;
    u32x4 xv[4];
#pragma unroll
    for (int tap = 0; tap < 4; ++tap) { const int tt = tl0 + ct + tap - 3; xv[tap] = (u32x4){0u, 0u, 0u, 0u};
        if (tt >= 0) xv[tap] = *(const u32x4*)(z + ((size_t)b * SEQ + tt) * DIN + ZX + cbase + c8); }
    BLOCK_SYNC();
    for (int c = 0; c < 8; ++c) {
        const size_t t0 = (size_t)b * SEQ + tl0 + c * 64;
        { float xc[8];
#pragma unroll
          for (int k = 0; k < 8; ++k) xc[k] = cb[k];
#pragma unroll
          for (int tap = 0; tap < 4; ++tap)
#pragma unroll
              for (int k = 0; k < 4; ++k) { xc[2 * k] += cw[tap][2 * k] * __uint_as_float(xv[tap][k] << 16); xc[2 * k + 1] += cw[tap][2 * k + 1] * __uint_as_float(xv[tap][k] & 0xffff0000u); }
          u32x4 w; w.x = cvt_pk_bf16(xc[0], xc[1]); w.y = cvt_pk_bf16(xc[2], xc[3]); w.z = cvt_pk_bf16(xc[4], xc[5]); w.w = cvt_pk_bf16(xc[6], xc[7]);
          *(LAS u32x4*)(XC + ct * SLD + c8) = w;
          *(LAS f32x4*)(XCf + ct * 64 + c8) = (f32x4){xc[0], xc[1], xc[2], xc[3]}; *(LAS f32x4*)(XCf + ct * 64 + c8 + 4) = (f32x4){xc[4], xc[5], xc[6], xc[7]}; }
        if (c + 1 < 8) {
#pragma unroll
            for (int tap = 0; tap < 4; ++tap) xv[tap] = *(const u32x4*)(z + (t0 + 64 + ct + tap - 3) * DIN + ZX + cbase + c8); }
        BLOCK_SYNC();
#pragma unroll
        for (int i = 0; i < 2; ++i) { const int jb = jh * 2 + i; const f32x4 zero = (f32x4){0.f, 0.f, 0.f, 0.f};
            const f32x4 ga = mma16<2>(XC + 16 * tb * SLD, SLD, WaT + 16 * jb * SLD, SLD, zero, fr, fq);
            const f32x4 gx = mma16<2>(XC + 16 * tb * SLD, SLD, WxT + 16 * jb * SLD, SLD, zero, fr, fq);
            const int t = 16 * tb + fr, col0 = 16 * jb + 4 * fq;
            const f32x4 xcv = *(const LAS f32x4*)(XCf + t * 64 + col0);
            f32x4 av, uv;
#pragma unroll
            for (int j = 0; j < 4; ++j) { const float r = fsigmoid(ga[j] + gba[i][j]), gi = fsigmoid(gx[j] + gbx[i][j]);
                const float la = -8.0f * r * gsp[i][j]; av[j] = __expf(la); uv[j] = __builtin_amdgcn_sqrtf(fmaxf(1.f - av[j] * av[j], 0.f)) * gi * xcv[j]; }
            *(LAS f32x4*)(Af + t * 64 + col0) = av; *(LAS f32x4*)(Uf + t * 64 + col0) = uv; }
        BLOCK_SYNC();
        { float av[8], uv[8]; float P = 1.f, H = 0.f;
#pragma unroll
          for (int k = 0; k < 8; ++k) { av[k] = Af[(wave * 8 + k) * 64 + lane]; uv[k] = Uf[(wave * 8 + k) * 64 + lane]; H = av[k] * H + uv[k]; P *= av[k]; }
          segP[wave * 64 + lane] = P; segH[wave * 64 + lane] = H;
          BLOCK_SYNC();
          float h = carry[lane], p = carry[64 + lane];
          for (int q = 0; q < wave; ++q) { const float sp = segP[q * 64 + lane]; h = sp * h + segH[q * 64 + lane]; p *= sp; }
          bf16* lh = (bf16*)LH + (t0 + wave * 8) * 256 + cbase + lane; bf16* lp = (bf16*)LP + (t0 + wave * 8) * 256 + cbase + lane;
#pragma unroll
          for (int k = 0; k < 8; ++k) { h = av[k] * h + uv[k]; p *= av[k]; lh[k * 256] = f2bf(h); lp[k * 256] = f2bf(p); }
          BLOCK_SYNC();
          if (wave == 7) { carry[lane] = h; carry[64 + lane] = p; } }
    }
    BLOCK_SYNC();
    if (tid < 64) { LE[item * 128 + tid] = carry[64 + tid]; LE[item * 128 + 64 + tid] = carry[tid]; }
    BLOCK_SYNC();
}
__device__ __forceinline__ void lru_pass2(CArgs& a, LAS unsigned char* lds, int layer, int bx, const bf16* z, bf16* mix, const float* LH, const float* LP, const float* LE) {
    const int tid = opaque_tid();
    const int b = bx >> 5, sgi = (bx >> 2) & 7;
    const int tl = tid >> 3, c8 = (tid & 7) * 8;
    LAS float* cinl = (LAS float*)lds;
    if (tid < 256) { const float* le = LE + (size_t)((b * 4 + (tid >> 6)) * 8) * 128 + (tid & 63);
        float P[7], H[7];
#pragma unroll
        for (int j = 0; j < 7; ++j) { P[j] = 0.f; H[j] = 0.f; if (j < sgi) { P[j] = le[j * 128]; H[j] = le[j * 128 + 64]; } }
        float c = 0.f;
#pragma unroll
        for (int j = 0; j < 7; ++j) if (j < sgi) c = P[j] * c + H[j];
        cinl[tid] = c; }
    BLOCK_SYNC();
#pragma unroll 1
    for (int blk = 0; blk < 4; ++blk) {
        const f32x4 ci0 = *(const LAS f32x4*)(cinl + blk * 64 + c8), ci1 = *(const LAS f32x4*)(cinl + blk * 64 + c8 + 4);
        const float cin[8] = {ci0[0], ci0[1], ci0[2], ci0[3], ci1[0], ci1[1], ci1[2], ci1[3]};
        const float* ng = a.in[I_LN] + layer * 256 + blk * 64 + c8;
        const f32x4 g0 = *(const f32x4*)ng, g1 = *(const f32x4*)(ng + 4);
        f32x4 h0[2], h1[2], p0[2], p1[2]; u32x4 gv[2];
#pragma unroll
        for (int hh = 0; hh < 2; ++hh) { const size_t t = (size_t)bx * 128 + hh * 64 + tl;
            const u32x4 hw = *(const u32x4*)((const bf16*)LH + t * 256 + blk * 64 + c8), pw = *(const u32x4*)((const bf16*)LP + t * 256 + blk * 64 + c8);
            h0[hh] = (f32x4){__uint_as_float(hw.x << 16), __uint_as_float(hw.x & 0xffff0000u), __uint_as_float(hw.y << 16), __uint_as_float(hw.y & 0xffff0000u)};
            h1[hh] = (f32x4){__uint_as_float(hw.z << 16), __uint_as_float(hw.z & 0xffff0000u), __uint_as_float(hw.w << 16), __uint_as_float(hw.w & 0xffff0000u)};
            p0[hh] = (f32x4){__uint_as_float(pw.x << 16), __uint_as_float(pw.x & 0xffff0000u), __uint_as_float(pw.y << 16), __uint_as_float(pw.y & 0xffff0000u)};
            p1[hh] = (f32x4){__uint_as_float(pw.z << 16), __uint_as_float(pw.z & 0xffff0000u), __uint_as_float(pw.w << 16), __uint_as_float(pw.w & 0xffff0000u)};
            gv[hh] = *(const u32x4*)(z + t * DIN + ZGATE + blk * 64 + c8); }
#pragma unroll
        for (int hh = 0; hh < 2; ++hh) { const size_t t = (size_t)bx * 128 + hh * 64 + tl;
            float y[8]; float ss = 0.f;
#pragma unroll
            for (int k = 0; k < 4; ++k) { const float ge = __uint_as_float(gv[hh][k] << 16), go = __uint_as_float(gv[hh][k] & 0xffff0000u);
                const float he = (k < 2 ? h0[hh][2 * k] : h1[hh][2 * k - 4]) + (k < 2 ? p0[hh][2 * k] : p1[hh][2 * k - 4]) * cin[2 * k];
                const float ho = (k < 2 ? h0[hh][2 * k + 1] : h1[hh][2 * k - 3]) + (k < 2 ? p0[hh][2 * k + 1] : p1[hh][2 * k - 3]) * cin[2 * k + 1];
                y[2 * k] = he * gelu_t(ge); y[2 * k + 1] = ho * gelu_t(go); ss += y[2 * k] * y[2 * k] + y[2 * k + 1] * y[2 * k + 1]; }
            ss += __shfl_xor(ss, 1); ss += __shfl_xor(ss, 2); ss += __shfl_xor(ss, 4);
            const float rs = rsqrtf(ss * (1.f / 64.f) + EPS);
            u32x4 w; w.x = cvt_pk_bf16(y[0] * rs * g0[0], y[1] * rs * g0[1]); w.y = cvt_pk_bf16(y[2] * rs * g0[2], y[3] * rs * g0[3]);
            w.z = cvt_pk_bf16(y[4] * rs * g1[0], y[5] * rs * g1[1]); w.w = cvt_pk_bf16(y[6] * rs * g1[2], y[7] * rs * g1[3]);
            *(u32x4*)(mix + t * D + 512 + blk * 64 + c8) = w; }
    }
    BLOCK_SYNC();
}

__device__ __forceinline__ void sgu_items(CArgs& a, LAS unsigned char* lds, int layer, int first, int stride, const bf16* z, bf16* mix) {
    const int tid = opaque_tid(), lane = tid & 63, wave = tid >> 6, fr = lane & 15, fq = lane >> 4;
    LAS bf16* Wm = (LAS bf16*)(lds);
    LAS bf16* VnT = (LAS bf16*)(lds + 34816);
    int cur_grp = -1;
    for (int it = first; it < BATCH * 32 * 4; it += stride) {
        const int grp = it & 3, bn = it >> 2; const size_t t0 = (size_t)bn * 128;
        if (grp != cur_grp) { cur_grp = grp;
            const float* ws = a.in[I_SW] + ((size_t)layer * 4 + grp) * 16384;
            for (int e = tid; e < 4096; e += NTHREADS) { const int t = e >> 5, s0 = (e & 31) * 4; const f32x4 wv = *(const f32x4*)(ws + t * 128 + s0);
                u32x2 w; w.x = cvt_pk_bf16(s0 <= t ? wv[0] : 0.f, s0 + 1 <= t ? wv[1] : 0.f); w.y = cvt_pk_bf16(s0 + 2 <= t ? wv[2] : 0.f, s0 + 3 <= t ? wv[3] : 0.f);
                *(LAS u32x2*)(Wm + t * QLD + s0) = w; } }
        { const int s = tid >> 2, cq = tid & 3; const bf16* vr = z + (t0 + s) * DIN + ZV + grp * 64 + cq * 16;
          const u32x4 r0 = *(const u32x4*)vr, r1 = *(const u32x4*)(vr + 8);
          float v[16]; float sum = 0.f;
#pragma unroll
          for (int k = 0; k < 4; ++k) { v[2 * k] = gelu_t(__uint_as_float(r0[k] << 16)); v[2 * k + 1] = gelu_t(__uint_as_float(r0[k] & 0xffff0000u));
              v[8 + 2 * k] = gelu_t(__uint_as_float(r1[k] << 16)); v[8 + 2 * k + 1] = gelu_t(__uint_as_float(r1[k] & 0xffff0000u)); }
#pragma unroll
          for (int k = 0; k < 16; ++k) sum += v[k];
          sum += __shfl_xor(sum, 1); sum += __shfl_xor(sum, 2);
          const float mu = sum * (1.f / 64.f); float sq = 0.f;
#pragma unroll
          for (int k = 0; k < 16; ++k) { v[k] -= mu; sq += v[k] * v[k]; }
          sq += __shfl_xor(sq, 1); sq += __shfl_xor(sq, 2);
          const float rs = rsqrtf(sq * (1.f / 64.f) + EPS);
#pragma unroll
          for (int k = 0; k < 16; ++k) VnT[(cq * 16 + k) * QLD + s] = f2bf(v[k] * rs); }
        BLOCK_SYNC();
        { const int t = 16 * wave + fr; f32x4 y[4]; float ss = 0.f;
          const float bias = a.in[I_SB][((size_t)layer * 4 + grp) * 128 + t];
          const bf16* ur = z + (t0 + t) * DIN + ZU + grp * 64;
#pragma unroll
          for (int cb = 0; cb < 4; ++cb) { f32x4 acc = (f32x4){0.f, 0.f, 0.f, 0.f};
              acc = mma16<4>(Wm + 16 * wave * QLD, QLD, VnT + 16 * cb * QLD, QLD, acc, fr, fq);
              const u32x2 uw = *(const u32x2*)(ur + 16 * cb + 4 * fq);
              const float u0 = __uint_as_float(uw.x << 16), u1 = __uint_as_float(uw.x & 0xffff0000u), u2 = __uint_as_float(uw.y << 16), u3 = __uint_as_float(uw.y & 0xffff0000u);
              y[cb] = (f32x4){gelu_t(u0) * (acc[0] + bias), gelu_t(u1) * (acc[1] + bias), gelu_t(u2) * (acc[2] + bias), gelu_t(u3) * (acc[3] + bias)};
              ss += (y[cb][0] * y[cb][0] + y[cb][1] * y[cb][1]) + (y[cb][2] * y[cb][2] + y[cb][3] * y[cb][3]); }
          ss += __shfl_xor(ss, 16); ss += __shfl_xor(ss, 32);
          const float rs = SG_SCALE * rsqrtf(ss * (1.f / 64.f) + EPS);
          const float* ng = a.in[I_SN] + layer * 256 + grp * 64; bf16* mr = mix + (t0 + t) * D + 768 + grp * 64;
#pragma unroll
          for (int cb = 0; cb < 4; ++cb) { const f32x4 gg = *(const f32x4*)(ng + 16 * cb + 4 * fq);
              u32x2 w; w.x = cvt_pk_bf16(y[cb][0] * rs * gg[0], y[cb][1] * rs * gg[1]); w.y = cvt_pk_bf16(y[cb][2] * rs * gg[2], y[cb][3] * rs * gg[3]);
              *(u32x2*)(mr + 16 * cb + 4 * fq) = w; } }
        BLOCK_SYNC();
    }
}

#define XB_TMO      128
#define XB_XCNT(j)  (256  + 64 * (j))
#define XB_XSUB(j)  (1280 + 64 * (j))
#define XB_XGEN(j)  (2304 + 64 * (j))
#define XB_TOP      3328
#define XB_TOPGEN   3392
#define XCD_BAR_WORDS 3456
#define XB_SPIN_CAP (1u << 18)

__device__ __forceinline__ unsigned xb_ld(unsigned* p)              { return __hip_atomic_load(p, __ATOMIC_RELAXED, __HIP_MEMORY_SCOPE_AGENT); }
__device__ __forceinline__ unsigned xb_add(unsigned* p, unsigned v) { return __hip_atomic_fetch_add(p, v, __ATOMIC_RELAXED, __HIP_MEMORY_SCOPE_AGENT); }
__device__ __forceinline__ unsigned xb_xcc_id() { return (unsigned)__builtin_amdgcn_s_getreg((3 << 11) | 20) & 0xFu; }
#define XB_SPIN(cond, bar) do { unsigned _sp = 0; while (cond) { __builtin_amdgcn_s_sleep(1); \
    if ((++_sp & 255u) == 0u) { if (xb_ld(&(bar)[XB_TMO])) break; if (_sp > XB_SPIN_CAP) { atomicAdd(&(bar)[XB_TMO], 1u); break; } } } } while (0)

struct XcdBarrier {
    unsigned* bar; unsigned x;
    volatile LAS unsigned* st;
};

__device__ __forceinline__ XcdBarrier xcd_barrier_post(unsigned* bar, volatile LAS unsigned* st) {
    XcdBarrier b; b.bar = bar; b.x = xb_xcc_id(); b.st = st;
    if (threadIdx.x == 0) (void)xb_add(&bar[XB_XCNT(b.x)], 1u);
    return b;
}
__device__ __forceinline__ void xcd_barrier_complete(unsigned* bar, unsigned x, unsigned& nloc, unsigned& nx) {
    const unsigned G = gridDim.x * gridDim.y * gridDim.z;
    unsigned sum, cnt, mine, sp = 0u;
    for (;;) {
        sum = 0u; cnt = 0u; mine = 0u;
#pragma unroll
        for (unsigned j = 0; j < 16; ++j) { const unsigned c = xb_ld(&bar[XB_XCNT(j)]); sum += c; cnt += (c > 0u) ? 1u : 0u; mine = (j == x) ? c : mine; }
        if (sum == G) break;
        __builtin_amdgcn_s_sleep(1);
        if ((++sp & 255u) == 0u) { if (xb_ld(&bar[XB_TMO])) break; if (sp > XB_SPIN_CAP) { atomicAdd(&bar[XB_TMO], 1u); break; } }
    }
    nloc = mine > 0u ? mine : 1u; nx = cnt > 0u ? cnt : 1u;
}

__device__ __forceinline__ void xcd_barrier(const XcdBarrier& b) {
    asm volatile("s_waitcnt vmcnt(0)" ::: "memory");
    __syncthreads();
    if (threadIdx.x == 0) {
        unsigned* bar = b.bar;
        __builtin_amdgcn_s_waitcnt(0);
        unsigned nloc = b.st[0], nx = b.st[1];
        if (nloc == 0u) { xcd_barrier_complete(bar, b.x, nloc, nx); b.st[0] = nloc; b.st[1] = nx; }
        const unsigned old = xb_add(&bar[XB_XSUB(b.x)], 1u);
        const unsigned gen = old / nloc;
        if (old + 1u == (gen + 1u) * nloc) {
            __builtin_amdgcn_fence(__ATOMIC_RELEASE, "agent");
            asm volatile("s_waitcnt vmcnt(0)" ::: "memory");
            const unsigned og = xb_add(&bar[XB_TOP], 1u);
            const unsigned tg = og / nx;
            if (og + 1u == (tg + 1u) * nx) xb_add(&bar[XB_TOPGEN], 1u);
            else XB_SPIN(xb_ld(&bar[XB_TOPGEN]) == tg, bar);
            __builtin_amdgcn_fence(__ATOMIC_ACQUIRE, "agent");
            xb_add(&bar[XB_XGEN(b.x)], 1u);
            asm volatile("s_waitcnt vmcnt(0)" ::: "memory");
        } else {
            XB_SPIN(xb_ld(&bar[XB_XGEN(b.x)]) == gen, bar);
            __builtin_amdgcn_fence(__ATOMIC_ACQUIRE, "agent");
            asm volatile("s_waitcnt vmcnt(0)" ::: "memory");
        }
    }
    __syncthreads();
}

template <class Epi, int ID>
__device__ __forceinline__ void run_gemm(LAS unsigned char* lds, const bf16* A, const bf16* Bt, int N, int K, int G, int bx, const Epi& E) {
#ifndef NO_GEMM
    if (ID & GEMM_MASK) return;
    pg8::Gemm g{A, Bt, T, N, K}; pg8::StaticOrder S; S.init(T, N, G, bx);
    pg8::gemm_phase<Epi, pg8::StaticOrder, true, true>(lds, g, S, E);
#endif
}
__device__ __forceinline__ CArgs* args_ptr() { CArgs* p = (CArgs*)__builtin_amdgcn_kernarg_segment_ptr(); asm volatile("" : "+s"(p)); return p; }
__global__ void __launch_bounds__(NTHREADS, 2) fwd_kernel(Args a_unused) {
    extern __shared__ __attribute__((aligned(16))) unsigned char lds_raw[];
    LAS unsigned char* lds = (LAS unsigned char*)lds_raw;
    cg::grid_group grid = cg::this_grid();
    volatile LAS unsigned* MISC = (volatile LAS unsigned*)(lds + 131072 + 320);
    if (threadIdx.x < 32) MISC[threadIdx.x] = 0u;
    __syncthreads();
    (void)xcd_barrier_post((unsigned*)args_ptr()->ws, MISC + 8);
#define GRID_BAR() do { XcdBarrier b_; b_.bar = (unsigned*)args_ptr()->ws; b_.x = xb_xcc_id(); b_.st = (volatile LAS unsigned*)(lds + 131072 + 320) + 8; xcd_barrier(b_); } while (0)
    const int tid = threadIdx.x, lane = tid & 63, wave = __builtin_amdgcn_readfirstlane(tid >> 6);
    const int G = gridDim.x, bx = blockIdx.x;
    const int gw = bx * NWAVES + wave, NGW = G * NWAVES;
    { CArgs& a = *args_ptr();
      convert_weights(a, lds, gw, NGW, wave, lane);
      norm_rows<false, false>(a.in[I_X], nullptr, 0.f, nullptr, a.in[I_F1N], (bf16*)(a.ws + WS_XN), nullptr, nullptr, gw, NGW, lane); }
    grid.sync();
    GRID_BAR();
    constexpr int NPH = 11;
#pragma nounroll
    for (int ph = 0; ph < DEPTH * NPH; ++ph) {
        const int layer = ph / NPH, p = ph - layer * NPH;
        CArgs& a = *args_ptr();
        bf16* h = (bf16*)a.out; bf16* xn = (bf16*)(a.ws + WS_XN); bf16* mix = xn; bf16* zb = (bf16*)(a.ws + WS_Z); bf16* act = zb;
        const bf16* wl = (const bf16*)(a.ws + WS_W + (size_t)layer * W_LAYER);
        if (p == 0 || p == 8) {
            run_gemm<pg8::EpiSwiGLU, 1>(lds, xn, wl + (p == 0 ? OFF_GU1 : OFF_GU2) / 2, 2 * FF, D, G, bx, pg8::EpiSwiGLU{act, FF});
        } else if (p == 1 || p == 9 || p == 3 || p == 6) {
            const bool dn = (p == 1 || p == 9);
            const bf16* A = dn ? act : xn; const size_t wo = (p == 1) ? OFF_D1 : (p == 9) ? OFF_D2 : (p == 3) ? OFF_IN : OFF_OUT;
            const int N = (p == 3) ? DIN : D, K = dn ? FF : D; bf16* O = dn ? xn : zb;
            run_gemm<pg8::EpiStoreBf16, 4>(lds, A, wl + wo / 2, N, K, G, bx, pg8::EpiStoreBf16{O, N});
        } else if (p == 4) {
            float* HS = (float*)(a.ws + WS_HS); float* HD = (float*)(a.ws + WS_HD);
            for (int it = bx; it < 256; it += G) if ((it & 7) != 7) hgrn_seg<false>(a, lds, layer, it, zb, mix, HS, HD);
            for (int it = bx; it < 256; it += G) lru_pass1(a, lds, layer, it, zb, (float*)(a.ws + WS_LH), (float*)(a.ws + WS_LP), (float*)(a.ws + WS_LE));
            sgu_items(a, lds, layer, bx, G, zb, mix);
        } else if (p == 5) {
            float* HS = (float*)(a.ws + WS_HS); float* HD = (float*)(a.ws + WS_HD);
            for (int it = bx; it < 256; it += G) hgrn_seg<true>(a, lds, layer, it, zb, mix, HS, HD);
            for (int it = bx; it < 256; it += G) lru_pass2(a, lds, layer, it, zb, mix, (const float*)(a.ws + WS_LH), (const float*)(a.ws + WS_LP), (const float*)(a.ws + WS_LE));
        } else {
            const bf16* y = (p == 7) ? zb : xn; const float ys = (p == 7) ? 1.0f : 0.5f; const int lane = opaque_tid() & 63;
            if (p == 10 && layer == DEPTH - 1) norm_rows<true, true>(h, y, ys, nullptr, a.in[I_FN], nullptr, a.out, (float*)(a.ws + WS_Z), gw, NGW, lane);
            else { const float* gain = (p == 2) ? a.in[I_MIXN] + layer * D : (p == 7) ? a.in[I_F2N] + layer * D : a.in[I_F1N] + (layer + 1) * D;
                if (ph == 2) norm_rows<false, false>(a.in[I_X], y, ys, h, gain, xn, nullptr, nullptr, gw, NGW, lane);
                else norm_rows<true, false>(h, y, ys, h, gain, xn, nullptr, nullptr, gw, NGW, lane); }
        }
        GRID_BAR();
    }
    { CArgs& a = *args_ptr(); copy_rows((const float*)(a.ws + WS_Z), a.out, gw, NGW, opaque_tid() & 63); }
}

extern "C" void kernel_launch(void* const* d_in, const int* in_sizes, int n_in, void* d_out, int out_size, void* d_ws, size_t ws_size, hipStream_t stream) {
    static int grid = 0;
    if (grid == 0) {
        if (n_in != 26 || in_sizes[0] != T * D || out_size != T * D || ws_size < WS_END) {
            fprintf(stderr, "kernel_launch: unexpected shapes: n_in %d in0 %d out %d ws %zu (need %zu)\n", n_in, n_in > 0 ? in_sizes[0] : -1, out_size, ws_size, (size_t)WS_END); grid = -1; return; }
        int dev = 0, cus = 0, per_cu = 0;
        (void)hipGetDevice(&dev); (void)hipDeviceGetAttribute(&cus, hipDeviceAttributeMultiprocessorCount, dev);
        if (hipFuncSetAttribute((const void*)fwd_kernel, hipFuncAttributeMaxDynamicSharedMemorySize, LDS_BYTES) != hipSuccess) { fprintf(stderr, "kernel_launch: hipFuncSetAttribute failed\n"); grid = -1; return; }
        if (hipOccupancyMaxActiveBlocksPerMultiprocessor(&per_cu, (const void*)fwd_kernel, NTHREADS, LDS_BYTES) != hipSuccess || per_cu < 1) { fprintf(stderr, "kernel_launch: occupancy query gave %d\n", per_cu); per_cu = 1; }
        (void)hipGetLastError();
        grid = cus * per_cu;
        if (grid < 128) { fprintf(stderr, "kernel_launch: grid %d too small\n", grid); grid = -1; return; }
    }
    if (grid < 0) return;
    if (hipMemsetAsync(d_ws, 0, 65536, stream) != hipSuccess) { fprintf(stderr, "kernel_launch: memset failed\n"); return; }
    Args a{};
    for (int i = 0; i < 26; ++i) a.in[i] = (const float*)d_in[i];
    a.out = (float*)d_out; a.ws = (unsigned char*)d_ws;
    void* args[] = {&a};
    hipError_t e = hipLaunchCooperativeKernel((const void*)fwd_kernel, dim3(grid), dim3(NTHREADS), args, LDS_BYTES, stream);
    if (e != hipSuccess) fprintf(stderr, "kernel_launch: cooperative launch failed: %s (grid %d)\n", hipGetErrorString(e), grid);
}
```
